# Optimizing an MI355X kernel written in HIP

```python
import jax, jax.numpy as jnp
from jax import lax
import numpy as np

D_MODEL = 2048
BATCH = 2
SEQ = 8192
DEPTH = 2

N_MIXERS = 2
CONV_WIDTH = 3
CHUNK = 128
SG_GROUPS = 8
SG_WIDTH = D_MODEL
D_FF = 5632
RMS_EPS = 1e-5
N_A = (DEPTH + 1) // 2
N_B = DEPTH // 2

kernel_name = "hybrid_shortconv_spatialgate_convffn"


def rmsnorm(x, g):
    xf = x.astype(jnp.float32)
    inv = lax.rsqrt(jnp.mean(xf * xf, axis=-1, keepdims=True) + RMS_EPS)
    return (xf * inv).astype(x.dtype) * g


def causal_dwconv3(x, w):
    s = x.shape[1]
    xp = jnp.pad(x, ((0, 0), (CONV_WIDTH - 1, 0), (0, 0)))
    return xp[:, :s] * w[0] + xp[:, 1:s + 1] * w[1] + xp[:, 2:s + 2] * w[2]


def short_conv_mixer(h, w_in, w_conv, w_out):
    bcx = jnp.einsum('bsd,de->bse', h, w_in)
    gb, gc, xs = jnp.split(bcx, 3, axis=-1)
    y = gb * causal_dwconv3(gc * xs, w_conv)
    return jnp.einsum('bsd,de->bse', y, w_out)


def spatial_gating_mixer(h, w_in, v_norm, w_s, b_s, w_out):
    bsz, s, _ = h.shape
    z = jax.nn.gelu(jnp.einsum('bsd,de->bse', h, w_in))
    u, v = jnp.split(z, 2, axis=-1)
    v = rmsnorm(v, v_norm)
    n_chunks = s // CHUNK
    vr = v.reshape(bsz, n_chunks, CHUNK, SG_GROUPS, SG_WIDTH // SG_GROUPS)
    mask = jnp.tril(jnp.ones((CHUNK, CHUNK), dtype=w_s.dtype))
    ws = w_s * mask
    mixed = jnp.einsum('hts,bnshc->bnthc', ws, vr) + b_s.T[None, None, :, :, None]
    gate = mixed.reshape(bsz, s, SG_WIDTH)
    return jnp.einsum('bsd,de->bse', u * gate, w_out)


def conv_ffn(h, w_up, conv_w, conv_b, w_down):
    up = jnp.einsum('bsd,df->bsf', h, w_up)
    up = causal_dwconv3(up, conv_w) + conv_b
    g, a = jnp.split(up, 2, axis=-1)
    return jnp.einsum('bsf,fd->bsd', jax.nn.silu(g) * a, w_down)


def setup_inputs(seed: int = 0) -> dict:
    key = jax.random.key(seed)
    ks = jax.random.split(key, 20)
    f32 = jnp.float32
    D = D_MODEL
    def nrm(k, shape, scale):
        return jax.random.normal(k, shape, f32) * scale
    def gain(k, shape):
        return 1.0 + 0.02 * jax.random.normal(k, shape, f32)
    return {
        "x": nrm(ks[0], (BATCH, SEQ, D), 1.0),
        "a_norm": gain(ks[1], (N_A, D)),
        "a_in": nrm(ks[2], (N_A, D, 3 * D), D ** -0.5),
        "a_conv": nrm(ks[3], (N_A, CONV_WIDTH, D), CONV_WIDTH ** -0.5),
        "a_out": nrm(ks[4], (N_A, D, D), D ** -0.5),
        "b_norm": gain(ks[5], (N_B, D)),
        "b_in": nrm(ks[6], (N_B, D, 2 * SG_WIDTH), D ** -0.5),
        "b_vnorm": gain(ks[7], (N_B, SG_WIDTH)),
        "b_ws": nrm(ks[8], (N_B, SG_GROUPS, CHUNK, CHUNK), CHUNK ** -0.5),
        "b_bs": gain(ks[9], (N_B, SG_GROUPS, CHUNK)),
        "b_out": nrm(ks[10], (N_B, SG_WIDTH, D), SG_WIDTH ** -0.5),
        "f_norm": gain(ks[11], (DEPTH, D)),
        "f_up": nrm(ks[12], (DEPTH, D, 2 * D_FF), D ** -0.5),
        "f_conv_w": nrm(ks[13], (DEPTH, CONV_WIDTH, 2 * D_FF), CONV_WIDTH ** -0.5),
        "f_conv_b": nrm(ks[14], (DEPTH, 2 * D_FF), 0.01),
        "f_down": nrm(ks[15], (DEPTH, D_FF, D), D_FF ** -0.5),
        "final_norm": gain(ks[16], (D,)),
    }


def reference(x, a_norm, a_in, a_conv, a_out, b_norm, b_in, b_vnorm, b_ws, b_bs, b_out,
              f_norm, f_up, f_conv_w, f_conv_b, f_down, final_norm):
    for i in range(DEPTH):
        j = i // N_MIXERS
        if i % N_MIXERS == 0:
            h = rmsnorm(x, a_norm[j])
            x = x + short_conv_mixer(h, a_in[j], a_conv[j], a_out[j])
        else:
            h = rmsnorm(x, b_norm[j])
            x = x + spatial_gating_mixer(h, b_in[j], b_vnorm[j], b_ws[j], b_bs[j], b_out[j])
        h = rmsnorm(x, f_norm[i])
        x = x + conv_ffn(h, f_up[i], f_conv_w[i], f_conv_b[i], f_down[i])
    return rmsnorm(x, final_norm)
```

```cpp
#include <hip/hip_runtime.h>
#include <hip/hip_cooperative_groups.h>
#include <cstdio>
namespace cg = cooperative_groups;

#define LAS __attribute__((address_space(3)))
typedef unsigned short bf16_t;
typedef short bf16x8 __attribute__((ext_vector_type(8)));
typedef float f32x4 __attribute__((ext_vector_type(4)));
typedef unsigned u32x4 __attribute__((ext_vector_type(4)));
typedef unsigned u32x2 __attribute__((ext_vector_type(2)));

constexpr int DM = 2048, SEQ = 8192, MROWS = 16384, DFF = 5632, NUP = 11264, NAIN = 6144, NBIN = 4096;
constexpr float RMS_EPS = 1e-5f;
constexpr size_t MiB = 1u << 20;
constexpr size_t OFF_SS = 0;
constexpr size_t OFF_W_AIN = 1 * MiB;
constexpr size_t OFF_W_AOUT = OFF_W_AIN + 24 * MiB;
constexpr size_t OFF_W_UP0 = OFF_W_AOUT + 8 * MiB;
constexpr size_t OFF_W_DN0 = OFF_W_UP0 + 44 * MiB;
constexpr size_t OFF_W_BIN = OFF_W_DN0 + 22 * MiB;
constexpr size_t OFF_W_BOUT = OFF_W_BIN + 16 * MiB;
constexpr size_t OFF_W_UP1 = OFF_W_BOUT + 8 * MiB;
constexpr size_t OFF_W_DN1 = OFF_W_UP1 + 44 * MiB;
constexpr size_t OFF_XB = OFF_W_DN1 + 22 * MiB;
constexpr size_t OFF_BIG = OFF_XB + 64 * MiB;
constexpr size_t OFF_HALO = OFF_BIG + 352 * MiB;
constexpr size_t WS_NEED = OFF_HALO + 22 * MiB;

constexpr int LDS_BYTES = 132096;

__device__ __forceinline__ unsigned cvt_pk_bf16(float lo, float hi) { unsigned r; asm volatile("v_cvt_pk_bf16_f32 %0, %1, %2" : "=v"(r) : "v"(lo), "v"(hi)); return r; }
__device__ __forceinline__ float bf_lo(unsigned w) { return __uint_as_float(w << 16); }
__device__ __forceinline__ float bf_hi(unsigned w) { return __uint_as_float(w & 0xffff0000u); }
__device__ __forceinline__ float wave_sum(float v) {
#pragma unroll
    for (int o = 1; o < 64; o <<= 1) v += __shfl_xor(v, o);
    return v;
}
__device__ __forceinline__ float fast_rcp(float x) { return __builtin_amdgcn_rcpf(x); }
__device__ __forceinline__ float gelu_tanh(float x) {
    const float u = 0.7978845608028654f * (x + 0.044715f * x * x * x);
    return x * fast_rcp(1.0f + __builtin_amdgcn_exp2f(-2.8853900817779268f * u));
}
__device__ __forceinline__ float silu(float x) { return x * fast_rcp(1.0f + __builtin_amdgcn_exp2f(-1.4426950408889634f * x)); }
__device__ __forceinline__ float inv_rms(float ss) { return 1.0f / sqrtf(ss * (1.0f / DM) + RMS_EPS); }

constexpr int BM = 256, BK = 64, HALF = 128, HTB = HALF * BK * 2, NXCD = 8, WGM = 8;
__device__ __forceinline__ int lds_byte(int r, int c) { const int st = (r >> 4) * 2 + (c >> 5), rr = r & 15, cc = c & 31, ob = rr * 64 + cc * 2; return st * 1024 + (ob ^ (((ob >> 9) & 1) << 5)); }
__device__ __forceinline__ void stage_rc(int b, int& R, int& C) { const int st = b / 1024, sb = b % 1024, swz = sb ^ (((sb >> 9) & 1) << 5); R = (st >> 1) * 16 + swz / 64; C = (st & 1) * 32 + (swz % 64) / 2; }
__device__ __forceinline__ int perm32(int rho) { const int n = rho >> 4, i = rho & 15; return 8 * (i >> 2) + 4 * n + (i & 3); }

struct Unit { int pm, pn; };
struct StaticOrder {
    int nM, nN, nwg, G, c;
    __device__ void init(int M, int N, int G_, int c_) { nM = M / BM; nN = N / BM; nwg = nM * nN; G = G_; c = c_; }
    __device__ bool next(int i, Unit& u) const {
        const long L = (long)i * G + c; if (L >= nwg) return false;
        int wgid = (int)L; { const int q = nwg / NXCD, r = nwg % NXCD, xcd = wgid % NXCD, off = wgid / NXCD; wgid = (xcd < r ? xcd * (q + 1) : r * (q + 1) + (xcd - r) * q) + off; }
        const int nig = WGM * nN, gid = wgid / nig, fm = gid * WGM, gsz = (nM - fm) < WGM ? (nM - fm) : WGM;
        u.pm = fm + ((wgid % nig) % gsz); u.pn = (wgid % nig) / gsz; return true;
    }
};

template <int MODE> struct Epi {
    bf16_t* O; int ldo; const float* ss_in; float* ss_out; const float* base; float* outf; bf16_t* xb; bf16_t* halo;
    __device__ __forceinline__ void operator()(const f32x4 (&acc)[2][2][4][2], const Unit& u, int wr, int wc, int fr, int fq) const {
        const int row0 = u.pm * BM + wr * 64 + fr, col0 = u.pn * BM + wc * 32 + 8 * fq;
#pragma unroll
        for (int ai = 0; ai < 2; ++ai)
#pragma unroll
            for (int m = 0; m < 4; ++m) {
                const int row = row0 + ai * HALF + m * 16;
                if (MODE != 3) {
                    const float inv = inv_rms(ss_in[row]);
                    float sq = 0.f;
#pragma unroll
                    for (int bj = 0; bj < 2; ++bj) {
                        f32x4 v0 = acc[ai][bj][m][0] * inv, v1 = acc[ai][bj][m][1] * inv;
                        if (MODE == 2) {
#pragma unroll
                            for (int j = 0; j < 4; ++j) { v0[j] = gelu_tanh(v0[j]); v1[j] = gelu_tanh(v1[j]); sq += v0[j] * v0[j] + v1[j] * v1[j]; }
                        }
                        u32x4 w; w.x = cvt_pk_bf16(v0[0], v0[1]); w.y = cvt_pk_bf16(v0[2], v0[3]); w.z = cvt_pk_bf16(v1[0], v1[1]); w.w = cvt_pk_bf16(v1[2], v1[3]);
                        *(u32x4*)(O + (size_t)row * ldo + col0 + bj * HALF) = w;
                        if (MODE == 1) { if ((m & 1) && fr >= 14) *(u32x4*)(halo + (size_t)((row >> 5) * 2 + (fr - 14)) * NUP + col0 + bj * HALF) = w; }
                    }
                    if (MODE == 2) {
                        if (u.pn >= 8) { sq += __shfl_xor(sq, 16); sq += __shfl_xor(sq, 32); if (fq == 0) atomicAdd(ss_out + row, sq); }
                    }
                } else {
                    float sq = 0.f;
#pragma unroll
                    for (int bj = 0; bj < 2; ++bj) {
                        const size_t off = (size_t)row * DM + col0 + bj * HALF;
                        const f32x4 b0 = *(const f32x4*)(base + off), b1 = *(const f32x4*)(base + off + 4);
                        const f32x4 v0 = acc[ai][bj][m][0] + b0, v1 = acc[ai][bj][m][1] + b1;
                        *(f32x4*)(outf + off) = v0; *(f32x4*)(outf + off + 4) = v1;
                        u32x4 w; w.x = cvt_pk_bf16(v0[0], v0[1]); w.y = cvt_pk_bf16(v0[2], v0[3]); w.z = cvt_pk_bf16(v1[0], v1[1]); w.w = cvt_pk_bf16(v1[2], v1[3]);
                        *(u32x4*)(xb + off) = w;
#pragma unroll
                        for (int j = 0; j < 4; ++j) sq += v0[j] * v0[j] + v1[j] * v1[j];
                    }
                    sq += __shfl_xor(sq, 16); sq += __shfl_xor(sq, 32);
                    if (fq == 0) atomicAdd(ss_out + row, sq);
                }
            }
    }
};

template <class EpiT>
__device__ __forceinline__ void gemm_phase(LAS unsigned char* lds, const bf16_t* A, int lda, const bf16_t* Bt, int Mg, int N, int K, const EpiT& E) {
    const int tid = threadIdx.x, wid = __builtin_amdgcn_readfirstlane(tid >> 6), lane = tid & 63, wr = wid >> 2, wc = wid & 3, fr = lane & 15, fq = lane >> 4;
    const int nt = K / BK;
    StaticOrder S; S.init(Mg, N, (int)gridDim.x, (int)blockIdx.x);
    unsigned voffA[2], voffB[2];
#pragma unroll
    for (int i = 0; i < 2; ++i) { int R, C; stage_rc(tid * 16 + i * 8192, R, C); const int Rb = (R & ~31) + perm32(R & 31);
        voffA[i] = (unsigned)(R * lda + C) * 2u; voffB[i] = (unsigned)(Rb * K + C) * 2u; }
    const size_t kstep = (size_t)(BK * 2);
    const size_t hstepA = (size_t)HALF * lda * 2, hstepB = (size_t)HALF * K * 2;
    const size_t tstepA = 2 * hstepA, tstepB = 2 * hstepB;
    const unsigned ldsw = (unsigned)wid * 1024u;
    const int aoff = lds_byte(wr * 64 + fr, fq * 8), boff = lds_byte(wc * 32 + fr, fq * 8);
#define PG8_SA(b, h) (((b) * 2 + (h)) * HTB)
#define PG8_SB(b, h) ((4 + (b) * 2 + (h)) * HTB)
#define PG8_STAGE(bufoff, gbase, voff) do { _Pragma("unroll") for (int _i = 0; _i < 2; ++_i) \
        __builtin_amdgcn_global_load_lds((const unsigned*)((const char*)(gbase) + (voff)[_i]), (LAS unsigned*)(lds + (bufoff) + ldsw + _i * 8192), 16, 0, 0); } while (0)
#define PG8_LDA(dst, b, h) do { _Pragma("unroll") for (int m = 0; m < 4; ++m) _Pragma("unroll") for (int k = 0; k < 2; ++k) dst[m][k] = *(const LAS bf16x8*)(lds + PG8_SA(b, h) + aoff + m * 2048 + k * 1024); } while (0)
#define PG8_LDB(dst, b, h) do { _Pragma("unroll") for (int n = 0; n < 2; ++n) _Pragma("unroll") for (int k = 0; k < 2; ++k) dst[n][k] = *(const LAS bf16x8*)(lds + PG8_SB(b, h) + boff + n * 2048 + k * 1024); } while (0)
#define PG8_MMA(ai, bj, At, Bt_) do { __builtin_amdgcn_s_setprio(1); _Pragma("unroll") for (int m = 0; m < 4; ++m) _Pragma("unroll") for (int n = 0; n < 2; ++n) _Pragma("unroll") for (int k = 0; k < 2; ++k) \
        acc[ai][bj][m][n] = __builtin_amdgcn_mfma_f32_16x16x32_bf16(Bt_[n][k], At[m][k], acc[ai][bj][m][n], 0, 0, 0); __builtin_amdgcn_s_setprio(0); } while (0)
#define PG8_WAIT_V(n) asm volatile("s_waitcnt vmcnt(" #n ")" ::: "memory")
#define PG8_WAIT_L(n) asm volatile("s_waitcnt lgkmcnt(" #n ")" ::: "memory")
#define PG8_BAR __builtin_amdgcn_s_barrier()
#define PG8_SCHED __builtin_amdgcn_sched_barrier(0)
    Unit cur, nxt; int ui = 0;
    if (!S.next(0, cur)) return;
    f32x4 acc[2][2][4][2];
#pragma unroll
    for (int a = 0; a < 2; ++a)
#pragma unroll
        for (int b = 0; b < 2; ++b)
#pragma unroll
            for (int m = 0; m < 4; ++m)
#pragma unroll
                for (int n = 0; n < 2; ++n) acc[a][b][m][n] = (f32x4){0.f, 0.f, 0.f, 0.f};
    bf16x8 At[4][2], B0[2][2], B1[2][2];
    const char* cA = (const char*)A + (size_t)cur.pm * tstepA; const char* cB = (const char*)Bt + (size_t)cur.pn * tstepB;
    PG8_STAGE(PG8_SB(0, 0), cB, voffB); PG8_STAGE(PG8_SA(0, 0), cA, voffA); PG8_STAGE(PG8_SB(0, 1), cB + hstepB, voffB); PG8_STAGE(PG8_SA(0, 1), cA + hstepA, voffA);
    if (wr == 1) PG8_BAR;
    PG8_WAIT_V(4); PG8_BAR;
    PG8_STAGE(PG8_SB(1, 0), cB + kstep, voffB); PG8_STAGE(PG8_SA(1, 0), cA + kstep, voffA); PG8_STAGE(PG8_SB(1, 1), cB + hstepB + kstep, voffB);
    PG8_WAIT_V(6); PG8_BAR;
    for (;;) {
        const bool has_next = S.next(ui + 1, nxt);
        const char* nA = has_next ? (const char*)A + (size_t)nxt.pm * tstepA : cA; const char* nB = has_next ? (const char*)Bt + (size_t)nxt.pn * tstepB : cB;
        for (int t = 0; t < nt; t += 2) {
            const bool last = (t == nt - 2);
            const char* a1 = cA + (size_t)(t + 1) * kstep;
            const char* a2 = last ? nA : cA + (size_t)(t + 2) * kstep; const char* b2 = last ? nB : cB + (size_t)(t + 2) * kstep;
            const char* a3 = a2 + kstep; const char* b3 = b2 + kstep;
            PG8_LDB(B0, 0, 0); PG8_SCHED; PG8_LDA(At, 0, 0); PG8_STAGE(PG8_SA(1, 1), a1 + hstepA, voffA);
            PG8_WAIT_L(8); PG8_BAR; PG8_WAIT_L(0); PG8_MMA(0, 0, At, B0); PG8_BAR; PG8_SCHED;
            PG8_LDB(B1, 0, 1); PG8_STAGE(PG8_SB(0, 0), b2, voffB);
            PG8_BAR; PG8_WAIT_L(0); PG8_MMA(0, 1, At, B1); PG8_BAR;
            PG8_LDA(At, 0, 1); PG8_STAGE(PG8_SA(0, 0), a2, voffA);
            PG8_BAR; PG8_WAIT_L(0); PG8_MMA(1, 0, At, B0); PG8_BAR; PG8_SCHED;
            PG8_STAGE(PG8_SB(0, 1), b2 + hstepB, voffB);
            PG8_WAIT_V(6); PG8_BAR; PG8_MMA(1, 1, At, B1); PG8_BAR;
            PG8_LDB(B0, 1, 0); PG8_SCHED; PG8_LDA(At, 1, 0); PG8_STAGE(PG8_SA(0, 1), a2 + hstepA, voffA);
            PG8_WAIT_L(8); PG8_BAR; PG8_WAIT_L(0); PG8_MMA(0, 0, At, B0); PG8_BAR; PG8_SCHED;
            PG8_LDB(B1, 1, 1); PG8_STAGE(PG8_SB(1, 0), b3, voffB);
            PG8_BAR; PG8_WAIT_L(0); PG8_MMA(0, 1, At, B1); PG8_BAR;
            PG8_LDA(At, 1, 1); PG8_STAGE(PG8_SA(1, 0), a3, voffA);
            PG8_BAR; PG8_WAIT_L(0); PG8_MMA(1, 0, At, B0); PG8_BAR; PG8_SCHED;
            PG8_STAGE(PG8_SB(1, 1), b3 + hstepB, voffB);
            PG8_WAIT_V(6); PG8_BAR; PG8_MMA(1, 1, At, B1); PG8_BAR;
        }
        E(acc, cur, wr, wc, fr, fq);
        if (!has_next) break;
#pragma unroll
        for (int a = 0; a < 2; ++a)
#pragma unroll
            for (int b = 0; b < 2; ++b)
#pragma unroll
                for (int m = 0; m < 4; ++m)
#pragma unroll
                    for (int n = 0; n < 2; ++n) acc[a][b][m][n] = (f32x4){0.f, 0.f, 0.f, 0.f};
        cur = nxt; cA = nA; cB = nB; ++ui;
    }
    PG8_WAIT_V(0);
    if (wr == 0) PG8_BAR;
    PG8_BAR;
#undef PG8_SA
#undef PG8_SB
#undef PG8_STAGE
#undef PG8_LDA
#undef PG8_LDB
#undef PG8_MMA
#undef PG8_WAIT_V
#undef PG8_WAIT_L
#undef PG8_BAR
#undef PG8_SCHED
}

__device__ __forceinline__ void p0_transpose_item(const float* W, int K, int N, bf16_t* WT, const float* gain, LAS float* scr, int item, int lane) {
    const int nblk = N / 32, kb = item / nblk, nb = item % nblk, k0 = 64 * kb, n0 = 32 * nb;
#pragma unroll 8
    for (int i = 0; i < 32; ++i) { const int kk = 2 * i + (lane >> 5); const float gk = gain ? gain[k0 + kk] : 1.0f; scr[kk * 33 + (lane & 31)] = W[(size_t)(k0 + kk) * N + n0 + (lane & 31)] * gk; }
    asm volatile("s_waitcnt lgkmcnt(0)" ::: "memory");
    const int c = lane & 7;
#pragma unroll
    for (int j = 0; j < 4; ++j) { const int n = (lane >> 3) + 8 * j; const LAS float* s = scr + (8 * c) * 33 + n;
        u32x4 o; o.x = cvt_pk_bf16(s[0 * 33], s[1 * 33]); o.y = cvt_pk_bf16(s[2 * 33], s[3 * 33]); o.z = cvt_pk_bf16(s[4 * 33], s[5 * 33]); o.w = cvt_pk_bf16(s[6 * 33], s[7 * 33]);
        *(u32x4*)(WT + (size_t)(n0 + n) * K + k0 + 8 * c) = o; }
    asm volatile("s_waitcnt lgkmcnt(0)" ::: "memory");
}

struct Params { const float* in[17]; float* out; unsigned char* ws; };

__device__ __forceinline__ void phase0(const Params& p, LAS unsigned char* lds, int gw, int NGW, int wave, int lane) {
    unsigned char* ws = p.ws;
    LAS float* scr = (LAS float*)(lds + wave * 16384);
    constexpr int I_AIN = (DM / 64) * (NAIN / 32), I_SQ = (DM / 64) * (DM / 32), I_UP = (DM / 64) * (NUP / 32), I_DN = (DFF / 64) * (DM / 32), I_BIN = (DM / 64) * (NBIN / 32);
    constexpr int NITEMS = I_AIN + 2 * I_SQ + 2 * I_UP + 2 * I_DN + I_BIN;
    for (int it = gw; it < NITEMS; it += NGW) {
        int r = it;
        if (r < I_AIN) { p0_transpose_item(p.in[2], DM, NAIN, (bf16_t*)(ws + OFF_W_AIN), p.in[1], scr, r, lane); continue; } r -= I_AIN;
        if (r < I_SQ) { p0_transpose_item(p.in[4], DM, DM, (bf16_t*)(ws + OFF_W_AOUT), nullptr, scr, r, lane); continue; } r -= I_SQ;
        if (r < I_UP) { p0_transpose_item(p.in[12], DM, NUP, (bf16_t*)(ws + OFF_W_UP0), p.in[11], scr, r, lane); continue; } r -= I_UP;
        if (r < I_DN) { p0_transpose_item(p.in[15], DFF, DM, (bf16_t*)(ws + OFF_W_DN0), nullptr, scr, r, lane); continue; } r -= I_DN;
        if (r < I_BIN) { p0_transpose_item(p.in[6], DM, NBIN, (bf16_t*)(ws + OFF_W_BIN), p.in[5], scr, r, lane); continue; } r -= I_BIN;
        if (r < I_SQ) { p0_transpose_item(p.in[10], DM, DM, (bf16_t*)(ws + OFF_W_BOUT), nullptr, scr, r, lane); continue; } r -= I_SQ;
        if (r < I_UP) { p0_transpose_item(p.in[12] + (size_t)DM * NUP, DM, NUP, (bf16_t*)(ws + OFF_W_UP1), p.in[11] + DM, scr, r, lane); continue; } r -= I_UP;
        p0_transpose_item(p.in[15] + (size_t)DFF * DM, DFF, DM, (bf16_t*)(ws + OFF_W_DN1), nullptr, scr, r, lane);
    }
    float* ss = (float*)(ws + OFF_SS);
    bf16_t* xb = (bf16_t*)(ws + OFF_XB);
    for (int m = gw; m < MROWS; m += NGW) {
        const f32x4* xr = (const f32x4*)(p.in[0] + (size_t)m * DM) + lane;
        f32x4 v[8]; float s = 0.f;
#pragma unroll
        for (int j = 0; j < 8; ++j) { v[j] = xr[64 * j]; s += (v[j][0] * v[j][0] + v[j][1] * v[j][1]) + (v[j][2] * v[j][2] + v[j][3] * v[j][3]); }
        s = wave_sum(s);
        u32x2* o = (u32x2*)(xb + (size_t)m * DM) + lane;
#pragma unroll
        for (int j = 0; j < 8; ++j) { u32x2 w; w.x = cvt_pk_bf16(v[j][0], v[j][1]); w.y = cvt_pk_bf16(v[j][2], v[j][3]); o[64 * j] = w; }
        if (lane == 0) ss[m] = s;
    }
    for (int i = gw * 64 + lane; i < 5 * MROWS; i += NGW * 64) ss[MROWS + i] = 0.f;
}

__device__ __forceinline__ void phase_mixA(bf16_t* bcx, const float* cw, int gw, int NGW, int lane) {
    for (int it = gw; it < (MROWS / 32) * 4; it += NGW) {
        const int seg = it >> 2, cb = it & 3, t0 = seg * 32, j = cb * 512 + lane * 8;
        float w0[8], w1[8], w2[8], pm2[8], pm1[8];
#pragma unroll
        for (int q = 0; q < 2; ++q) { const f32x4 a = *(const f32x4*)(cw + j + 4 * q), b = *(const f32x4*)(cw + DM + j + 4 * q), c = *(const f32x4*)(cw + 2 * DM + j + 4 * q);
#pragma unroll
            for (int e = 0; e < 4; ++e) { w0[4 * q + e] = a[e]; w1[4 * q + e] = b[e]; w2[4 * q + e] = c[e]; } }
        if ((t0 & (SEQ - 1)) == 0) {
#pragma unroll
            for (int e = 0; e < 8; ++e) { pm2[e] = 0.f; pm1[e] = 0.f; }
        } else {
            const bf16_t* r2 = bcx + (size_t)(t0 - 2) * NAIN + j; const bf16_t* r1 = bcx + (size_t)(t0 - 1) * NAIN + j;
            const u32x4 c2 = *(const u32x4*)(r2 + DM), x2 = *(const u32x4*)(r2 + 2 * DM), c1 = *(const u32x4*)(r1 + DM), x1 = *(const u32x4*)(r1 + 2 * DM);
#pragma unroll
            for (int e = 0; e < 4; ++e) { pm2[2 * e] = bf_lo(c2[e]) * bf_lo(x2[e]); pm2[2 * e + 1] = bf_hi(c2[e]) * bf_hi(x2[e]); pm1[2 * e] = bf_lo(c1[e]) * bf_lo(x1[e]); pm1[2 * e + 1] = bf_hi(c1[e]) * bf_hi(x1[e]); }
        }
#pragma unroll 4
        for (int r = 0; r < 32; ++r) {
            bf16_t* rp = bcx + (size_t)(t0 + r) * NAIN + j;
            const u32x4 gb = *(const u32x4*)rp, gc = *(const u32x4*)(rp + DM), xs = *(const u32x4*)(rp + 2 * DM);
            float y[8];
#pragma unroll
            for (int e = 0; e < 4; ++e) {
                const float p0 = bf_lo(gc[e]) * bf_lo(xs[e]), p1 = bf_hi(gc[e]) * bf_hi(xs[e]);
                y[2 * e] = bf_lo(gb[e]) * (w0[2 * e] * pm2[2 * e] + w1[2 * e] * pm1[2 * e] + w2[2 * e] * p0);
                y[2 * e + 1] = bf_hi(gb[e]) * (w0[2 * e + 1] * pm2[2 * e + 1] + w1[2 * e + 1] * pm1[2 * e + 1] + w2[2 * e + 1] * p1);
                pm2[2 * e] = pm1[2 * e]; pm2[2 * e + 1] = pm1[2 * e + 1]; pm1[2 * e] = p0; pm1[2 * e + 1] = p1;
            }
            u32x4 w; w.x = cvt_pk_bf16(y[0], y[1]); w.y = cvt_pk_bf16(y[2], y[3]); w.z = cvt_pk_bf16(y[4], y[5]); w.w = cvt_pk_bf16(y[6], y[7]);
            *(u32x4*)rp = w;
        }
    }
}

__device__ __forceinline__ void phase_ffn_act(bf16_t* up, const bf16_t* halo, const float* cw, const float* cbias, int gw, int NGW, int lane) {
    for (int it = gw; it < (MROWS / 32) * 11; it += NGW) {
        const int seg = it / 11, cb = it - seg * 11, t0 = seg * 32, j = cb * 512 + lane * 8;
        float wg0[8], wg1[8], wg2[8], wa0[8], wa1[8], wa2[8], bg[8], ba[8], g2[8], g1[8], a2[8], a1[8];
#pragma unroll
        for (int q = 0; q < 2; ++q) {
            const f32x4 x0 = *(const f32x4*)(cw + j + 4 * q), x1 = *(const f32x4*)(cw + NUP + j + 4 * q), x2 = *(const f32x4*)(cw + 2 * NUP + j + 4 * q);
            const f32x4 y0 = *(const f32x4*)(cw + DFF + j + 4 * q), y1 = *(const f32x4*)(cw + NUP + DFF + j + 4 * q), y2 = *(const f32x4*)(cw + 2 * NUP + DFF + j + 4 * q);
            const f32x4 b0 = *(const f32x4*)(cbias + j + 4 * q), b1 = *(const f32x4*)(cbias + DFF + j + 4 * q);
#pragma unroll
            for (int e = 0; e < 4; ++e) { wg0[4 * q + e] = x0[e]; wg1[4 * q + e] = x1[e]; wg2[4 * q + e] = x2[e]; wa0[4 * q + e] = y0[e]; wa1[4 * q + e] = y1[e]; wa2[4 * q + e] = y2[e]; bg[4 * q + e] = b0[e]; ba[4 * q + e] = b1[e]; }
        }
        if ((t0 & (SEQ - 1)) == 0) {
#pragma unroll
            for (int e = 0; e < 8; ++e) { g2[e] = 0.f; g1[e] = 0.f; a2[e] = 0.f; a1[e] = 0.f; }
        } else {
            const bf16_t* h2 = halo + (size_t)((seg - 1) * 2) * NUP + j; const bf16_t* h1 = h2 + NUP;
            const u32x4 G2 = *(const u32x4*)h2, A2 = *(const u32x4*)(h2 + DFF), G1 = *(const u32x4*)h1, A1 = *(const u32x4*)(h1 + DFF);
#pragma unroll
            for (int e = 0; e < 4; ++e) { g2[2 * e] = bf_lo(G2[e]); g2[2 * e + 1] = bf_hi(G2[e]); a2[2 * e] = bf_lo(A2[e]); a2[2 * e + 1] = bf_hi(A2[e]);
                g1[2 * e] = bf_lo(G1[e]); g1[2 * e + 1] = bf_hi(G1[e]); a1[2 * e] = bf_lo(A1[e]); a1[2 * e + 1] = bf_hi(A1[e]); }
        }
#pragma unroll 4
        for (int r = 0; r < 32; ++r) {
            bf16_t* rp = up + (size_t)(t0 + r) * NUP + j;
            const u32x4 Gv = *(const u32x4*)rp, Av = *(const u32x4*)(rp + DFF);
            float y[8];
#pragma unroll
            for (int e = 0; e < 8; ++e) {
                const float gcur = (e & 1) ? bf_hi(Gv[e >> 1]) : bf_lo(Gv[e >> 1]);
                const float acur = (e & 1) ? bf_hi(Av[e >> 1]) : bf_lo(Av[e >> 1]);
                const float cgv = wg0[e] * g2[e] + wg1[e] * g1[e] + wg2[e] * gcur + bg[e];
                const float cav = wa0[e] * a2[e] + wa1[e] * a1[e] + wa2[e] * acur + ba[e];
                y[e] = silu(cgv) * cav;
                g2[e] = g1[e]; g1[e] = gcur; a2[e] = a1[e]; a1[e] = acur;
            }
            u32x4 w; w.x = cvt_pk_bf16(y[0], y[1]); w.y = cvt_pk_bf16(y[2], y[3]); w.z = cvt_pk_bf16(y[4], y[5]); w.w = cvt_pk_bf16(y[6], y[7]);
            *(u32x4*)rp = w;
        }
    }
}

__device__ __forceinline__ void phase_sg(LAS unsigned char* lds, bf16_t* z, const float* wsp, const float* bs, const float* gv, const float* ssv) {
    constexpr int LP = 136;
    LAS bf16_t* As = (LAS bf16_t*)lds;
    LAS bf16_t* Vt = (LAS bf16_t*)(lds + 128 * LP * 2);
    const int tid = threadIdx.x, wid = tid >> 6, lane = tid & 63, fr = lane & 15, fq = lane >> 4, tb = wid >> 2, cb = wid & 3;
    for (int it = blockIdx.x; it < (MROWS / 128) * 8; it += gridDim.x) {
        const int n = it >> 3, h = it & 7, r0 = n * 128, c0 = h * 256;
        {
            const int s4 = (tid & 31) * 4; float iv[4];
#pragma unroll
            for (int i = 0; i < 4; ++i) iv[i] = inv_rms(ssv[r0 + s4 + i]);
#pragma unroll
            for (int i2 = 0; i2 < 8; ++i2) { const int t = (tid >> 5) + i2 * 16; const f32x4 w = *(const f32x4*)(wsp + (size_t)(h * 128 + t) * 128 + s4);
                float a[4];
#pragma unroll
                for (int i = 0; i < 4; ++i) a[i] = (s4 + i <= t) ? w[i] * iv[i] : 0.f;
                u32x2 o; o.x = cvt_pk_bf16(a[0], a[1]); o.y = cvt_pk_bf16(a[2], a[3]);
                *(LAS u32x2*)(As + t * LP + s4) = o; }
        }
#pragma unroll
        for (int i2 = 0; i2 < 8; ++i2) {
            const int q = i2 * 512 + tid, s = q & 127, cc = q >> 7;
            const u32x4 v = *(const u32x4*)(z + (size_t)(r0 + s) * NBIN + DM + c0 + cc * 8);
#pragma unroll
            for (int i = 0; i < 4; ++i) { Vt[(cc * 8 + 2 * i) * LP + s] = (bf16_t)(v[i] & 0xffffu); Vt[(cc * 8 + 2 * i + 1) * LP + s] = (bf16_t)(v[i] >> 16); }
        }
        __syncthreads();
        f32x4 acc[4][4];
#pragma unroll
        for (int mi = 0; mi < 4; ++mi)
#pragma unroll
            for (int ni = 0; ni < 4; ++ni) acc[mi][ni] = (f32x4){0.f, 0.f, 0.f, 0.f};
#pragma unroll
        for (int ks = 0; ks < 4; ++ks) {
            bf16x8 a[4], b[4];
#pragma unroll
            for (int mi = 0; mi < 4; ++mi) a[mi] = *(const LAS bf16x8*)(As + (tb * 64 + mi * 16 + fr) * LP + ks * 32 + fq * 8);
#pragma unroll
            for (int ni = 0; ni < 4; ++ni) b[ni] = *(const LAS bf16x8*)(Vt + (cb * 64 + ni * 16 + fr) * LP + ks * 32 + fq * 8);
#pragma unroll
            for (int mi = 0; mi < 4; ++mi)
#pragma unroll
                for (int ni = 0; ni < 4; ++ni) acc[mi][ni] = __builtin_amdgcn_mfma_f32_16x16x32_bf16(b[ni], a[mi], acc[mi][ni], 0, 0, 0);
        }
#pragma unroll
        for (int mi = 0; mi < 4; ++mi) {
            const int t = tb * 64 + mi * 16 + fr; const float bias = bs[h * 128 + t];
#pragma unroll
            for (int ni = 0; ni < 4; ++ni) {
                const int c = cb * 64 + ni * 16 + 4 * fq;
                const f32x4 g = *(const f32x4*)(gv + c0 + c);
                bf16_t* up = z + (size_t)(r0 + t) * NBIN + c0 + c;
                const u32x2 uu = *(const u32x2*)up;
                const float o0 = bf_lo(uu.x) * (g[0] * acc[mi][ni][0] + bias), o1 = bf_hi(uu.x) * (g[1] * acc[mi][ni][1] + bias);
                const float o2 = bf_lo(uu.y) * (g[2] * acc[mi][ni][2] + bias), o3 = bf_hi(uu.y) * (g[3] * acc[mi][ni][3] + bias);
                u32x2 o; o.x = cvt_pk_bf16(o0, o1); o.y = cvt_pk_bf16(o2, o3);
                *(u32x2*)up = o;
            }
        }
        __syncthreads();
    }
}

__device__ __forceinline__ void phase_final(float* out, const float* ss, const float* g, int gw, int NGW, int lane) {
    for (int m = gw; m < MROWS; m += NGW) {
        const float inv = inv_rms(ss[m]);
        f32x4* xr = (f32x4*)(out + (size_t)m * DM) + lane; const f32x4* gr = (const f32x4*)g + lane;
#pragma unroll
        for (int j = 0; j < 8; ++j) { const f32x4 v = xr[64 * j]; const f32x4 gg = gr[64 * j]; xr[64 * j] = (v * inv) * gg; }
    }
}

__global__ void __launch_bounds__(512, 2) fwd_megakernel(Params p) {
    extern __shared__ __attribute__((aligned(16))) unsigned char lds_raw[];
    LAS unsigned char* lds = (LAS unsigned char*)lds_raw;
    cg::grid_group grid = cg::this_grid();
    const int tid = threadIdx.x, lane = tid & 63, wave = __builtin_amdgcn_readfirstlane(tid >> 6);
    const int gw = blockIdx.x * 8 + wave, NGW = gridDim.x * 8;
    unsigned char* ws = p.ws;
    float* ss = (float*)(ws + OFF_SS);
    float *ss0 = ss, *ss1 = ss + MROWS, *ss2 = ss + 2 * MROWS, *ssv = ss + 3 * MROWS, *ss3 = ss + 4 * MROWS, *ss4 = ss + 5 * MROWS;
    bf16_t* xb = (bf16_t*)(ws + OFF_XB);
    bf16_t* big = (bf16_t*)(ws + OFF_BIG);
    bf16_t* halo = (bf16_t*)(ws + OFF_HALO);
    float* out = p.out;

    phase0(p, lds, gw, NGW, wave, lane);
    grid.sync();
    { Epi<0> E{big, NAIN, ss0, nullptr, nullptr, nullptr, nullptr, nullptr};
      gemm_phase(lds, xb, DM, (const bf16_t*)(ws + OFF_W_AIN), MROWS, NAIN, DM, E); }
    grid.sync();
    phase_mixA(big, p.in[3], gw, NGW, lane);
    grid.sync();
    { Epi<3> E{nullptr, 0, nullptr, ss1, p.in[0], out, xb, nullptr};
      gemm_phase(lds, big, NAIN, (const bf16_t*)(ws + OFF_W_AOUT), MROWS, DM, DM, E); }
    grid.sync();
    { Epi<1> E{big, NUP, ss1, nullptr, nullptr, nullptr, nullptr, halo};
      gemm_phase(lds, xb, DM, (const bf16_t*)(ws + OFF_W_UP0), MROWS, NUP, DM, E); }
    grid.sync();
    phase_ffn_act(big, halo, p.in[13], p.in[14], gw, NGW, lane);
    grid.sync();
    { Epi<3> E{nullptr, 0, nullptr, ss2, out, out, xb, nullptr};
      gemm_phase(lds, big, NUP, (const bf16_t*)(ws + OFF_W_DN0), MROWS, DM, DFF, E); }
    grid.sync();
    { Epi<2> E{big, NBIN, ss2, ssv, nullptr, nullptr, nullptr, nullptr};
      gemm_phase(lds, xb, DM, (const bf16_t*)(ws + OFF_W_BIN), MROWS, NBIN, DM, E); }
    grid.sync();
    phase_sg(lds, big, p.in[8], p.in[9], p.in[7], ssv);
    grid.sync();
    { Epi<3> E{nullptr, 0, nullptr, ss3, out, out, xb, nullptr};
      gemm_phase(lds, big, NBIN, (const bf16_t*)(ws + OFF_W_BOUT), MROWS, DM, DM, E); }
    grid.sync();
    { Epi<1> E{big, NUP, ss3, nullptr, nullptr, nullptr, nullptr, halo};
      gemm_phase(lds, xb, DM, (const bf16_t*)(ws + OFF_W_UP1), MROWS, NUP, DM, E); }
    grid.sync();
    phase_ffn_act(big, halo, p.in[13] + 3 * NUP, p.in[14] + NUP, gw, NGW, lane);
    grid.sync();
    { Epi<3> E{nullptr, 0, nullptr, ss4, out, out, xb, nullptr};
      gemm_phase(lds, big, NUP, (const bf16_t*)(ws + OFF_W_DN1), MROWS, DM, DFF, E); }
    grid.sync();
    phase_final(out, ss4, p.in[16], gw, NGW, lane);
}

extern "C" void kernel_launch(void* const* d_in, const int* in_sizes, int n_in, void* d_out, int out_size, void* d_ws, size_t ws_size, hipStream_t stream) {
    static int grid_blocks = 0;
    if (grid_blocks == 0) {
        if (n_in != 17 || out_size != MROWS * DM || ws_size < WS_NEED) { fprintf(stderr, "kernel_launch: unexpected problem (n_in %d out %d ws %zu need %zu)\n", n_in, out_size, ws_size, (size_t)WS_NEED); grid_blocks = -1; return; }
        int dev = 0, cus = 0, per_cu = 0;
        hipGetDevice(&dev);
        hipDeviceGetAttribute(&cus, hipDeviceAttributeMultiprocessorCount, dev);
        if (hipFuncSetAttribute((const void*)fwd_megakernel, hipFuncAttributeMaxDynamicSharedMemorySize, LDS_BYTES) != hipSuccess) { fprintf(stderr, "kernel_launch: hipFuncSetAttribute failed\n"); grid_blocks = -1; return; }
        if (hipOccupancyMaxActiveBlocksPerMultiprocessor(&per_cu, (const void*)fwd_megakernel, 512, LDS_BYTES) != hipSuccess || per_cu < 1) { fprintf(stderr, "kernel_launch: occupancy query gave %d\n", per_cu); per_cu = 1; }
        (void)hipGetLastError();
        grid_blocks = cus * per_cu;
    }
    if (grid_blocks < 0) return;
    Params p{};
    for (int i = 0; i < 17; ++i) p.in[i] = (const float*)d_in[i];
    p.out = (float*)d_out; p.ws = (unsigned char*)d_ws;
    void* args[] = {&p};
    hipError_t e = hipLaunchCooperativeKernel((const void*)fwd_megakernel, dim3(grid_blocks), dim3(512), args, LDS_BYTES, stream);
    if (e != hipSuccess) fprintf(stderr, "cooperative launch failed: %s (grid %d)\n", hipGetErrorString(e), grid_blocks);
}
```

```cpp
#include <hip/hip_runtime.h>
#include <hip/hip_cooperative_groups.h>
#include <cstdio>
namespace cg = cooperative_groups;

#define LAS __attribute__((address_space(3)))
typedef unsigned short bf16_t;
typedef short bf16x8 __attribute__((ext_vector_type(8)));
typedef float f32x4 __attribute__((ext_vector_type(4)));
typedef unsigned u32x4 __attribute__((ext_vector_type(4)));
typedef unsigned u32x2 __attribute__((ext_vector_type(2)));

constexpr int DM = 2048, SEQ = 8192, MROWS = 16384, DFF = 5632, NUP = 11264, NAIN = 6144, NBIN = 4096;
constexpr float RMS_EPS = 1e-5f;
constexpr size_t MiB = 1u << 20;
constexpr size_t OFF_SS = 0;
constexpr size_t OFF_BAR = 512 * 1024;
constexpr size_t OFF_W_AIN = 1 * MiB;
constexpr size_t OFF_W_AOUT = OFF_W_AIN + 24 * MiB;
constexpr size_t OFF_W_UP0 = OFF_W_AOUT + 8 * MiB;
constexpr size_t OFF_W_DN0 = OFF_W_UP0 + 44 * MiB;
constexpr size_t OFF_W_BIN = OFF_W_DN0 + 22 * MiB;
constexpr size_t OFF_W_BOUT = OFF_W_BIN + 16 * MiB;
constexpr size_t OFF_W_UP1 = OFF_W_BOUT + 8 * MiB;
constexpr size_t OFF_W_DN1 = OFF_W_UP1 + 44 * MiB;
constexpr size_t OFF_XB = OFF_W_DN1 + 22 * MiB;
constexpr size_t OFF_BIG = OFF_XB + 64 * MiB;
constexpr size_t OFF_HALO = OFF_BIG + 352 * MiB;
constexpr size_t WS_NEED = OFF_HALO + 22 * MiB;

constexpr int LDS_BYTES = 132096;

__device__ __forceinline__ unsigned cvt_pk_bf16(float lo, float hi) { unsigned r; asm volatile("v_cvt_pk_bf16_f32 %0, %1, %2" : "=v"(r) : "v"(lo), "v"(hi)); return r; }
__device__ __forceinline__ float bf_lo(unsigned w) { return __uint_as_float(w << 16); }
__device__ __forceinline__ float bf_hi(unsigned w) { return __uint_as_float(w & 0xffff0000u); }
__device__ __forceinline__ float wave_sum(float v) {
#pragma unroll
    for (int o = 1; o < 64; o <<= 1) v += __shfl_xor(v, o);
    return v;
}
__device__ __forceinline__ float fast_rcp(float x) { return __builtin_amdgcn_rcpf(x); }
__device__ __forceinline__ float gelu_tanh(float x) {
    const float u = 0.7978845608028654f * (x + 0.044715f * x * x * x);
    return x * fast_rcp(1.0f + __builtin_amdgcn_exp2f(-2.8853900817779268f * u));
}
__device__ __forceinline__ float silu(float x) { return x * fast_rcp(1.0f + __builtin_amdgcn_exp2f(-1.4426950408889634f * x)); }
__device__ __forceinline__ float inv_rms(float ss) { return 1.0f / sqrtf(ss * (1.0f / DM) + RMS_EPS); }


#define XB_TMO      128
#define XB_XCNT(j)  (256  + 64 * (j))
#define XB_XSUB(j)  (1280 + 64 * (j))
#define XB_XGEN(j)  (2304 + 64 * (j))
#define XB_TOP      3328
#define XB_TOPGEN   3392
#define XCD_BAR_WORDS 3456
#define XB_SPIN_CAP (1u << 22)
__device__ __forceinline__ unsigned xb_ld(unsigned* p)              { return __hip_atomic_load(p, __ATOMIC_RELAXED, __HIP_MEMORY_SCOPE_AGENT); }
__device__ __forceinline__ unsigned xb_add(unsigned* p, unsigned v) { return __hip_atomic_fetch_add(p, v, __ATOMIC_RELAXED, __HIP_MEMORY_SCOPE_AGENT); }
__device__ __forceinline__ unsigned xb_xcc_id() { return (unsigned)__builtin_amdgcn_s_getreg((3 << 11) | 20) & 0xFu; }
#define XB_SPIN(cond, bar) do { unsigned _sp = 0; while (cond) { __builtin_amdgcn_s_sleep(1); \
    if ((++_sp & 255u) == 0u) { if (xb_ld(&(bar)[XB_TMO])) break; if (_sp > XB_SPIN_CAP) { atomicAdd(&(bar)[XB_TMO], 1u); break; } } } } while (0)
struct XcdBarrier { unsigned* bar; unsigned x; volatile LAS unsigned* st; };
__device__ __forceinline__ XcdBarrier xcd_barrier_post(unsigned* bar, volatile LAS unsigned* st) {
    XcdBarrier b; b.bar = bar; b.x = xb_xcc_id(); b.st = st;
    if (threadIdx.x == 0) (void)xb_add(&bar[XB_XCNT(b.x)], 1u);
    return b;
}
__device__ __forceinline__ void xcd_barrier_complete(unsigned* bar, unsigned x, unsigned& nloc, unsigned& nx) {
    const unsigned G = gridDim.x * gridDim.y * gridDim.z;
    unsigned sum, cnt, mine, sp = 0u;
    for (;;) {
        sum = 0u; cnt = 0u; mine = 0u;
#pragma unroll
        for (unsigned j = 0; j < 16; ++j) { const unsigned c = xb_ld(&bar[XB_XCNT(j)]); sum += c; cnt += (c > 0u) ? 1u : 0u; mine = (j == x) ? c : mine; }
        if (sum == G) break;
        __builtin_amdgcn_s_sleep(1);
        if ((++sp & 255u) == 0u) { if (xb_ld(&bar[XB_TMO])) break; if (sp > XB_SPIN_CAP) { atomicAdd(&bar[XB_TMO], 1u); break; } }
    }
    nloc = mine > 0u ? mine : 1u; nx = cnt > 0u ? cnt : 1u;
}
__device__ __forceinline__ void xcd_barrier(const XcdBarrier& b) {
    asm volatile("s_waitcnt vmcnt(0)" ::: "memory");
    __syncthreads();
    if (threadIdx.x == 0) {
        unsigned* bar = b.bar;
        __builtin_amdgcn_s_waitcnt(0);
        unsigned nloc = b.st[0], nx = b.st[1];
        if (nloc == 0u) { xcd_barrier_complete(bar, b.x, nloc, nx); b.st[0] = nloc; b.st[1] = nx; }
        const unsigned old = xb_add(&bar[XB_XSUB(b.x)], 1u);
        const unsigned gen = old / nloc;
        if (old + 1u == (gen + 1u) * nloc) {
            __builtin_amdgcn_fence(__ATOMIC_RELEASE, "agent");
            asm volatile("s_waitcnt vmcnt(0)" ::: "memory");
            const unsigned og = xb_add(&bar[XB_TOP], 1u);
            const unsigned tg = og / nx;
            if (og + 1u == (tg + 1u) * nx) xb_add(&bar[XB_TOPGEN], 1u);
            else XB_SPIN(xb_ld(&bar[XB_TOPGEN]) == tg, bar);
            __builtin_amdgcn_fence(__ATOMIC_ACQUIRE, "agent");
            xb_add(&bar[XB_XGEN(b.x)], 1u);
            asm volatile("s_waitcnt vmcnt(0)" ::: "memory");
        } else {
            XB_SPIN(xb_ld(&bar[XB_XGEN(b.x)]) == gen, bar);
            __builtin_amdgcn_fence(__ATOMIC_ACQUIRE, "agent");
            asm volatile("s_waitcnt vmcnt(0)" ::: "memory");
        }
    }
    __syncthreads();
}

constexpr int BM = 256, BK = 64, HALF = 128, HTB = HALF * BK * 2, NXCD = 8, WGM = 8;
__device__ __forceinline__ int lds_byte(int r, int c) { const int st = (r >> 4) * 2 + (c >> 5), rr = r & 15, cc = c & 31, ob = rr * 64 + cc * 2; return st * 1024 + (ob ^ (((ob >> 9) & 1) << 5)); }
__device__ __forceinline__ void stage_rc(int b, int& R, int& C) { const int st = b / 1024, sb = b % 1024, swz = sb ^ (((sb >> 9) & 1) << 5); R = (st >> 1) * 16 + swz / 64; C = (st & 1) * 32 + (swz % 64) / 2; }
__device__ __forceinline__ int perm32(int rho) { const int n = rho >> 4, i = rho & 15; return 8 * (i >> 2) + 4 * n + (i & 3); }

struct Unit { int pm, pn; };
struct StaticOrder {
    int nM, nN, nwg, G, c;
    __device__ void init(int M, int N, int G_, int c_) { nM = M / BM; nN = N / BM; nwg = nM * nN; G = G_; c = c_; }
    __device__ bool next(int i, Unit& u) const {
        const long L = (long)i * G + c; if (L >= nwg) return false;
        int wgid = (int)L; { const int q = nwg / NXCD, r = nwg % NXCD, xcd = wgid % NXCD, off = wgid / NXCD; wgid = (xcd < r ? xcd * (q + 1) : r * (q + 1) + (xcd - r) * q) + off; }
        const int nig = WGM * nN, gid = wgid / nig, fm = gid * WGM, gsz = (nM - fm) < WGM ? (nM - fm) : WGM;
        u.pm = fm + ((wgid % nig) % gsz); u.pn = (wgid % nig) / gsz; return true;
    }
};

template <int MODE> struct Epi {
    bf16_t* O; int ldo; const float* ss_in; float* ss_out; const float* base; float* outf; bf16_t* xb; bf16_t* halo;
    __device__ __forceinline__ void operator()(const f32x4 (&acc)[2][2][4][2], const Unit& u, int wr, int wc, int fr, int fq) const {
        const int row0 = u.pm * BM + wr * 64 + fr, col0 = u.pn * BM + wc * 32 + 8 * fq;
#pragma unroll
        for (int ai = 0; ai < 2; ++ai)
#pragma unroll
            for (int m = 0; m < 4; ++m) {
                const int row = row0 + ai * HALF + m * 16;
                if (MODE != 3) {
                    const float inv = inv_rms(ss_in[row]);
                    float sq = 0.f;
#pragma unroll
                    for (int bj = 0; bj < 2; ++bj) {
                        f32x4 v0 = acc[ai][bj][m][0] * inv, v1 = acc[ai][bj][m][1] * inv;
                        if (MODE == 2) {
#pragma unroll
                            for (int j = 0; j < 4; ++j) { v0[j] = gelu_tanh(v0[j]); v1[j] = gelu_tanh(v1[j]); sq += v0[j] * v0[j] + v1[j] * v1[j]; }
                        }
                        u32x4 w; w.x = cvt_pk_bf16(v0[0], v0[1]); w.y = cvt_pk_bf16(v0[2], v0[3]); w.z = cvt_pk_bf16(v1[0], v1[1]); w.w = cvt_pk_bf16(v1[2], v1[3]);
                        *(u32x4*)(O + (size_t)row * ldo + col0 + bj * HALF) = w;
                        if (MODE == 1) { if ((m & 1) && fr >= 14) *(u32x4*)(halo + (size_t)((row >> 5) * 2 + (fr - 14)) * NUP + col0 + bj * HALF) = w; }
                    }
                    if (MODE == 2) {
                        if (u.pn >= 8) { sq += __shfl_xor(sq, 16); sq += __shfl_xor(sq, 32); if (fq == 0) atomicAdd(ss_out + row, sq); }
                    }
                } else {
                    float sq = 0.f;
#pragma unroll
                    for (int bj = 0; bj < 2; ++bj) {
                        const size_t off = (size_t)row * DM + col0 + bj * HALF;
                        const f32x4 b0 = *(const f32x4*)(base + off), b1 = *(const f32x4*)(base + off + 4);
                        const f32x4 v0 = acc[ai][bj][m][0] + b0, v1 = acc[ai][bj][m][1] + b1;
                        *(f32x4*)(outf + off) = v0; *(f32x4*)(outf + off + 4) = v1;
                        u32x4 w; w.x = cvt_pk_bf16(v0[0], v0[1]); w.y = cvt_pk_bf16(v0[2], v0[3]); w.z = cvt_pk_bf16(v1[0], v1[1]); w.w = cvt_pk_bf16(v1[2], v1[3]);
                        *(u32x4*)(xb + off) = w;
#pragma unroll
                        for (int j = 0; j < 4; ++j) sq += v0[j] * v0[j] + v1[j] * v1[j];
                    }
                    sq += __shfl_xor(sq, 16); sq += __shfl_xor(sq, 32);
                    if (fq == 0) atomicAdd(ss_out + row, sq);
                }
            }
    }
};

template <class EpiT>
__device__ __forceinline__ void gemm_phase(LAS unsigned char* lds, const bf16_t* A, int lda, const bf16_t* Bt, int Mg, int N, int K, const EpiT& E) {
    const int tid = threadIdx.x, wid = __builtin_amdgcn_readfirstlane(tid >> 6), lane = tid & 63, wr = wid >> 2, wc = wid & 3, fr = lane & 15, fq = lane >> 4;
    const int nt = K / BK;
    StaticOrder S; S.init(Mg, N, (int)gridDim.x, (int)blockIdx.x);
    unsigned voffA[2], voffB[2];
#pragma unroll
    for (int i = 0; i < 2; ++i) { int R, C; stage_rc(tid * 16 + i * 8192, R, C); const int Rb = (R & ~31) + perm32(R & 31);
        voffA[i] = (unsigned)(R * lda + C) * 2u; voffB[i] = (unsigned)(Rb * K + C) * 2u; }
    const size_t kstep = (size_t)(BK * 2);
    const size_t hstepA = (size_t)HALF * lda * 2, hstepB = (size_t)HALF * K * 2;
    const size_t tstepA = 2 * hstepA, tstepB = 2 * hstepB;
    const unsigned ldsw = (unsigned)wid * 1024u;
    const int aoff = lds_byte(wr * 64 + fr, fq * 8), boff = lds_byte(wc * 32 + fr, fq * 8);
#define PG8_SA(b, h) (((b) * 2 + (h)) * HTB)
#define PG8_SB(b, h) ((4 + (b) * 2 + (h)) * HTB)
#define PG8_STAGE(bufoff, gbase, voff) do { _Pragma("unroll") for (int _i = 0; _i < 2; ++_i) \
        __builtin_amdgcn_global_load_lds((const unsigned*)((const char*)(gbase) + (voff)[_i]), (LAS unsigned*)(lds + (bufoff) + ldsw + _i * 8192), 16, 0, 0); } while (0)
#define PG8_LDA(dst, b, h) do { _Pragma("unroll") for (int m = 0; m < 4; ++m) _Pragma("unroll") for (int k = 0; k < 2; ++k) dst[m][k] = *(const LAS bf16x8*)(lds + PG8_SA(b, h) + aoff + m * 2048 + k * 1024); } while (0)
#define PG8_LDB(dst, b, h) do { _Pragma("unroll") for (int n = 0; n < 2; ++n) _Pragma("unroll") for (int k = 0; k < 2; ++k) dst[n][k] = *(const LAS bf16x8*)(lds + PG8_SB(b, h) + boff + n * 2048 + k * 1024); } while (0)
#define PG8_MMA(ai, bj, At, Bt_) do { __builtin_amdgcn_s_setprio(1); _Pragma("unroll") for (int m = 0; m < 4; ++m) _Pragma("unroll") for (int n = 0; n < 2; ++n) _Pragma("unroll") for (int k = 0; k < 2; ++k) \
        acc[ai][bj][m][n] = __builtin_amdgcn_mfma_f32_16x16x32_bf16(Bt_[n][k], At[m][k], acc[ai][bj][m][n], 0, 0, 0); __builtin_amdgcn_s_setprio(0); } while (0)
#define PG8_WAIT_V(n) asm volatile("s_waitcnt vmcnt(" #n ")" ::: "memory")
#define PG8_WAIT_L(n) asm volatile("s_waitcnt lgkmcnt(" #n ")" ::: "memory")
#define PG8_BAR __builtin_amdgcn_s_barrier()
#define PG8_SCHED __builtin_amdgcn_sched_barrier(0)
    Unit cur, nxt; int ui = 0;
    if (!S.next(0, cur)) return;
    f32x4 acc[2][2][4][2];
#pragma unroll
    for (int a = 0; a < 2; ++a)
#pragma unroll
        for (int b = 0; b < 2; ++b)
#pragma unroll
            for (int m = 0; m < 4; ++m)
#pragma unroll
                for (int n = 0; n < 2; ++n) acc[a][b][m][n] = (f32x4){0.f, 0.f, 0.f, 0.f};
    bf16x8 At[4][2], B0[2][2], B1[2][2];
    const char* cA = (const char*)A + (size_t)cur.pm * tstepA; const char* cB = (const char*)Bt + (size_t)cur.pn * tstepB;
    PG8_STAGE(PG8_SB(0, 0), cB, voffB); PG8_STAGE(PG8_SA(0, 0), cA, voffA); PG8_STAGE(PG8_SB(0, 1), cB + hstepB, voffB); PG8_STAGE(PG8_SA(0, 1), cA + hstepA, voffA);
    if (wr == 1) PG8_BAR;
    PG8_WAIT_V(4); PG8_BAR;
    PG8_STAGE(PG8_SB(1, 0), cB + kstep, voffB); PG8_STAGE(PG8_SA(1, 0), cA + kstep, voffA); PG8_STAGE(PG8_SB(1, 1), cB + hstepB + kstep, voffB);
    PG8_WAIT_V(6); PG8_BAR;
    for (;;) {
        const bool has_next = S.next(ui + 1, nxt);
        const char* nA = has_next ? (const char*)A + (size_t)nxt.pm * tstepA : cA; const char* nB = has_next ? (const char*)Bt + (size_t)nxt.pn * tstepB : cB;
        for (int t = 0; t < nt; t += 2) {
            const bool last = (t == nt - 2);
            const char* a1 = cA + (size_t)(t + 1) * kstep;
            const char* a2 = last ? nA : cA + (size_t)(t + 2) * kstep; const char* b2 = last ? nB : cB + (size_t)(t + 2) * kstep;
            const char* a3 = a2 + kstep; const char* b3 = b2 + kstep;
            PG8_LDB(B0, 0, 0); PG8_SCHED; PG8_LDA(At, 0, 0); PG8_STAGE(PG8_SA(1, 1), a1 + hstepA, voffA);
            PG8_WAIT_L(8); PG8_BAR; PG8_WAIT_L(0); PG8_MMA(0, 0, At, B0); PG8_BAR; PG8_SCHED;
            PG8_LDB(B1, 0, 1); PG8_STAGE(PG8_SB(0, 0), b2, voffB);
            PG8_BAR; PG8_WAIT_L(0); PG8_MMA(0, 1, At, B1); PG8_BAR;
            PG8_LDA(At, 0, 1); PG8_STAGE(PG8_SA(0, 0), a2, voffA);
            PG8_BAR; PG8_WAIT_L(0); PG8_MMA(1, 0, At, B0); PG8_BAR; PG8_SCHED;
            PG8_STAGE(PG8_SB(0, 1), b2 + hstepB, voffB);
            PG8_WAIT_V(6); PG8_BAR; PG8_MMA(1, 1, At, B1); PG8_BAR;
            PG8_LDB(B0, 1, 0); PG8_SCHED; PG8_LDA(At, 1, 0); PG8_STAGE(PG8_SA(0, 1), a2 + hstepA, voffA);
            PG8_WAIT_L(8); PG8_BAR; PG8_WAIT_L(0); PG8_MMA(0, 0, At, B0); PG8_BAR; PG8_SCHED;
            PG8_LDB(B1, 1, 1); PG8_STAGE(PG8_SB(1, 0), b3, voffB);
            PG8_BAR; PG8_WAIT_L(0); PG8_MMA(0, 1, At, B1); PG8_BAR;
            PG8_LDA(At, 1, 1); PG8_STAGE(PG8_SA(1, 0), a3, voffA);
            PG8_BAR; PG8_WAIT_L(0); PG8_MMA(1, 0, At, B0); PG8_BAR; PG8_SCHED;
            PG8_STAGE(PG8_SB(1, 1), b3 + hstepB, voffB);
            PG8_WAIT_V(6); PG8_BAR; PG8_MMA(1, 1, At, B1); PG8_BAR;
        }
        E(acc, cur, wr, wc, fr, fq);
        if (!has_next) break;
#pragma unroll
        for (int a = 0; a < 2; ++a)
#pragma unroll
            for (int b = 0; b < 2; ++b)
#pragma unroll
                for (int m = 0; m < 4; ++m)
#pragma unroll
                    for (int n = 0; n < 2; ++n) acc[a][b][m][n] = (f32x4){0.f, 0.f, 0.f, 0.f};
        cur = nxt; cA = nA; cB = nB; ++ui;
    }
    PG8_WAIT_V(0);
    if (wr == 0) PG8_BAR;
    PG8_BAR;
#undef PG8_SA
#undef PG8_SB
#undef PG8_STAGE
#undef PG8_LDA
#undef PG8_LDB
#undef PG8_MMA
#undef PG8_WAIT_V
#undef PG8_WAIT_L
#undef PG8_BAR
#undef PG8_SCHED
}

__device__ __forceinline__ void p0_transpose_item(const float* W, int K, int N, bf16_t* WT, const float* gain, LAS float* scr, int item, int lane) {
    const int nblk = N / 32, kb = item / nblk, nb = item % nblk, k0 = 64 * kb, n0 = 32 * nb;
#pragma unroll
    for (int i = 0; i < 32; ++i) { const int kk = 2 * i + (lane >> 5); const float gk = gain ? gain[k0 + kk] : 1.0f; scr[kk * 33 + (lane & 31)] = W[(size_t)(k0 + kk) * N + n0 + (lane & 31)] * gk; }
    asm volatile("s_waitcnt lgkmcnt(0)" ::: "memory");
    const int c = lane & 7;
#pragma unroll
    for (int j = 0; j < 4; ++j) { const int n = (lane >> 3) + 8 * j; const LAS float* s = scr + (8 * c) * 33 + n;
        u32x4 o; o.x = cvt_pk_bf16(s[0 * 33], s[1 * 33]); o.y = cvt_pk_bf16(s[2 * 33], s[3 * 33]); o.z = cvt_pk_bf16(s[4 * 33], s[5 * 33]); o.w = cvt_pk_bf16(s[6 * 33], s[7 * 33]);
        *(u32x4*)(WT + (size_t)(n0 + n) * K + k0 + 8 * c) = o; }
    asm volatile("s_waitcnt lgkmcnt(0)" ::: "memory");
}

struct Params { const float* in[17]; float* out; unsigned char* ws; };

__device__ __forceinline__ void phase0(const Params& p, LAS unsigned char* lds, int gw, int NGW, int wave, int lane) {
    unsigned char* ws = p.ws;
    LAS float* scr = (LAS float*)(lds + wave * 16384);
    constexpr int I_AIN = (DM / 64) * (NAIN / 32), I_SQ = (DM / 64) * (DM / 32), I_UP = (DM / 64) * (NUP / 32), I_DN = (DFF / 64) * (DM / 32), I_BIN = (DM / 64) * (NBIN / 32);
    constexpr int NITEMS = I_AIN + 2 * I_SQ + 2 * I_UP + 2 * I_DN + I_BIN;
    for (int it = gw; it < NITEMS; it += NGW) {
        int r = it;
        if (r < I_AIN) { p0_transpose_item(p.in[2], DM, NAIN, (bf16_t*)(ws + OFF_W_AIN), p.in[1], scr, r, lane); continue; } r -= I_AIN;
        if (r < I_SQ) { p0_transpose_item(p.in[4], DM, DM, (bf16_t*)(ws + OFF_W_AOUT), nullptr, scr, r, lane); continue; } r -= I_SQ;
        if (r < I_UP) { p0_transpose_item(p.in[12], DM, NUP, (bf16_t*)(ws + OFF_W_UP0), p.in[11], scr, r, lane); continue; } r -= I_UP;
        if (r < I_DN) { p0_transpose_item(p.in[15], DFF, DM, (bf16_t*)(ws + OFF_W_DN0), nullptr, scr, r, lane); continue; } r -= I_DN;
        if (r < I_BIN) { p0_transpose_item(p.in[6], DM, NBIN, (bf16_t*)(ws + OFF_W_BIN), p.in[5], scr, r, lane); continue; } r -= I_BIN;
        if (r < I_SQ) { p0_transpose_item(p.in[10], DM, DM, (bf16_t*)(ws + OFF_W_BOUT), nullptr, scr, r, lane); continue; } r -= I_SQ;
        if (r < I_UP) { p0_transpose_item(p.in[12] + (size_t)DM * NUP, DM, NUP, (bf16_t*)(ws + OFF_W_UP1), p.in[11] + DM, scr, r, lane); continue; } r -= I_UP;
        p0_transpose_item(p.in[15] + (size_t)DFF * DM, DFF, DM, (bf16_t*)(ws + OFF_W_DN1), nullptr, scr, r, lane);
    }
    float* ss = (float*)(ws + OFF_SS);
    bf16_t* xb = (bf16_t*)(ws + OFF_XB);
    for (int m = gw; m < MROWS; m += NGW) {
        const f32x4* xr = (const f32x4*)(p.in[0] + (size_t)m * DM) + lane;
        f32x4 v[8]; float s = 0.f;
#pragma unroll
        for (int j = 0; j < 8; ++j) { v[j] = xr[64 * j]; s += (v[j][0] * v[j][0] + v[j][1] * v[j][1]) + (v[j][2] * v[j][2] + v[j][3] * v[j][3]); }
        s = wave_sum(s);
        u32x2* o = (u32x2*)(xb + (size_t)m * DM) + lane;
#pragma unroll
        for (int j = 0; j < 8; ++j) { u32x2 w; w.x = cvt_pk_bf16(v[j][0], v[j][1]); w.y = cvt_pk_bf16(v[j][2], v[j][3]); o[64 * j] = w; }
        if (lane == 0) ss[m] = s;
    }
    if (gw < 8) { unsigned* bw = (unsigned*)(ws + OFF_BAR); for (int i = gw * 64 + lane; i < 3456; i += 512) bw[i] = 0u; }
    for (int i = gw * 64 + lane; i < 5 * MROWS; i += NGW * 64) ss[MROWS + i] = 0.f;
}

__device__ __forceinline__ void phase_mixA(bf16_t* bcx, const float* cw, int gw, int NGW, int lane) {
    for (int it = gw; it < (MROWS / 32) * 4; it += NGW) {
        const int seg = it >> 2, cb = it & 3, t0 = seg * 32, j = cb * 512 + lane * 8;
        float w0[8], w1[8], w2[8], pm2[8], pm1[8];
#pragma unroll
        for (int q = 0; q < 2; ++q) { const f32x4 a = *(const f32x4*)(cw + j + 4 * q), b = *(const f32x4*)(cw + DM + j + 4 * q), c = *(const f32x4*)(cw + 2 * DM + j + 4 * q);
#pragma unroll
            for (int e = 0; e < 4; ++e) { w0[4 * q + e] = a[e]; w1[4 * q + e] = b[e]; w2[4 * q + e] = c[e]; } }
        if ((t0 & (SEQ - 1)) == 0) {
#pragma unroll
            for (int e = 0; e < 8; ++e) { pm2[e] = 0.f; pm1[e] = 0.f; }
        } else {
            const bf16_t* r2 = bcx + (size_t)(t0 - 2) * NAIN + j; const bf16_t* r1 = bcx + (size_t)(t0 - 1) * NAIN + j;
            const u32x4 c2 = *(const u32x4*)(r2 + DM), x2 = *(const u32x4*)(r2 + 2 * DM), c1 = *(const u32x4*)(r1 + DM), x1 = *(const u32x4*)(r1 + 2 * DM);
#pragma unroll
            for (int e = 0; e < 4; ++e) { pm2[2 * e] = bf_lo(c2[e]) * bf_lo(x2[e]); pm2[2 * e + 1] = bf_hi(c2[e]) * bf_hi(x2[e]); pm1[2 * e] = bf_lo(c1[e]) * bf_lo(x1[e]); pm1[2 * e + 1] = bf_hi(c1[e]) * bf_hi(x1[e]); }
        }
#pragma unroll 4
        for (int r = 0; r < 32; ++r) {
            bf16_t* rp = bcx + (size_t)(t0 + r) * NAIN + j;
            const u32x4 gb = *(const u32x4*)rp, gc = *(const u32x4*)(rp + DM), xs = *(const u32x4*)(rp + 2 * DM);
            float y[8];
#pragma unroll
            for (int e = 0; e < 4; ++e) {
                const float p0 = bf_lo(gc[e]) * bf_lo(xs[e]), p1 = bf_hi(gc[e]) * bf_hi(xs[e]);
                y[2 * e] = bf_lo(gb[e]) * (w0[2 * e] * pm2[2 * e] + w1[2 * e] * pm1[2 * e] + w2[2 * e] * p0);
                y[2 * e + 1] = bf_hi(gb[e]) * (w0[2 * e + 1] * pm2[2 * e + 1] + w1[2 * e + 1] * pm1[2 * e + 1] + w2[2 * e + 1] * p1);
                pm2[2 * e] = pm1[2 * e]; pm2[2 * e + 1] = pm1[2 * e + 1]; pm1[2 * e] = p0; pm1[2 * e + 1] = p1;
            }
            u32x4 w; w.x = cvt_pk_bf16(y[0], y[1]); w.y = cvt_pk_bf16(y[2], y[3]); w.z = cvt_pk_bf16(y[4], y[5]); w.w = cvt_pk_bf16(y[6], y[7]);
            *(u32x4*)rp = w;
        }
    }
}

__device__ __forceinline__ void phase_ffn_act(bf16_t* up, const bf16_t* halo, const float* cw, const float* cbias, int gw, int NGW, int lane) {
    for (int it = gw; it < (MROWS / 32) * 11; it += NGW) {
        const int seg = it / 11, cb = it - seg * 11, t0 = seg * 32, j = cb * 512 + lane * 8;
        float wg0[8], wg1[8], wg2[8], wa0[8], wa1[8], wa2[8], bg[8], ba[8], g2[8], g1[8], a2[8], a1[8];
#pragma unroll
        for (int q = 0; q < 2; ++q) {
            const f32x4 x0 = *(const f32x4*)(cw + j + 4 * q), x1 = *(const f32x4*)(cw + NUP + j + 4 * q), x2 = *(const f32x4*)(cw + 2 * NUP + j + 4 * q);
            const f32x4 y0 = *(const f32x4*)(cw + DFF + j + 4 * q), y1 = *(const f32x4*)(cw + NUP + DFF + j + 4 * q), y2 = *(const f32x4*)(cw + 2 * NUP + DFF + j + 4 * q);
            const f32x4 b0 = *(const f32x4*)(cbias + j + 4 * q), b1 = *(const f32x4*)(cbias + DFF + j + 4 * q);
#pragma unroll
            for (int e = 0; e < 4; ++e) { wg0[4 * q + e] = x0[e]; wg1[4 * q + e] = x1[e]; wg2[4 * q + e] = x2[e]; wa0[4 * q + e] = y0[e]; wa1[4 * q + e] = y1[e]; wa2[4 * q + e] = y2[e]; bg[4 * q + e] = b0[e]; ba[4 * q + e] = b1[e]; }
        }
        if ((t0 & (SEQ - 1)) == 0) {
#pragma unroll
            for (int e = 0; e < 8; ++e) { g2[e] = 0.f; g1[e] = 0.f; a2[e] = 0.f; a1[e] = 0.f; }
        } else {
            const bf16_t* h2 = halo + (size_t)((seg - 1) * 2) * NUP + j; const bf16_t* h1 = h2 + NUP;
            const u32x4 G2 = *(const u32x4*)h2, A2 = *(const u32x4*)(h2 + DFF), G1 = *(const u32x4*)h1, A1 = *(const u32x4*)(h1 + DFF);
#pragma unroll
            for (int e = 0; e < 4; ++e) { g2[2 * e] = bf_lo(G2[e]); g2[2 * e + 1] = bf_hi(G2[e]); a2[2 * e] = bf_lo(A2[e]); a2[2 * e + 1] = bf_hi(A2[e]);
                g1[2 * e] = bf_lo(G1[e]); g1[2 * e + 1] = bf_hi(G1[e]); a1[2 * e] = bf_lo(A1[e]); a1[2 * e + 1] = bf_hi(A1[e]); }
        }
#pragma unroll 4
        for (int r = 0; r < 32; ++r) {
            bf16_t* rp = up + (size_t)(t0 + r) * NUP + j;
            const u32x4 Gv = *(const u32x4*)rp, Av = *(const u32x4*)(rp + DFF);
            float y[8];
#pragma unroll
            for (int e = 0; e < 8; ++e) {
                const float gcur = (e & 1) ? bf_hi(Gv[e >> 1]) : bf_lo(Gv[e >> 1]);
                const float acur = (e & 1) ? bf_hi(Av[e >> 1]) : bf_lo(Av[e >> 1]);
                const float cgv = wg0[e] * g2[e] + wg1[e] * g1[e] + wg2[e] * gcur + bg[e];
                const float cav = wa0[e] * a2[e] + wa1[e] * a1[e] + wa2[e] * acur + ba[e];
                y[e] = silu(cgv) * cav;
                g2[e] = g1[e]; g1[e] = gcur; a2[e] = a1[e]; a1[e] = acur;
            }
            u32x4 w; w.x = cvt_pk_bf16(y[0], y[1]); w.y = cvt_pk_bf16(y[2], y[3]); w.z = cvt_pk_bf16(y[4], y[5]); w.w = cvt_pk_bf16(y[6], y[7]);
            *(u32x4*)rp = w;
        }
    }
}

__device__ __forceinline__ void phase_sg(LAS unsigned char* lds, bf16_t* z, const float* wsp, const float* bs, const float* gv, const float* ssv) {
    constexpr int LP = 136;
    LAS bf16_t* As = (LAS bf16_t*)lds;
    LAS bf16_t* Vt = (LAS bf16_t*)(lds + 128 * LP * 2);
    const int tid = threadIdx.x, wid = tid >> 6, lane = tid & 63, fr = lane & 15, fq = lane >> 4, tb = wid >> 2, cb = wid & 3;
    for (int it = blockIdx.x; it < (MROWS / 128) * 8; it += gridDim.x) {
        const int n = it >> 3, h = it & 7, r0 = n * 128, c0 = h * 256;
        {
            const int s4 = (tid & 31) * 4; float iv[4];
#pragma unroll
            for (int i = 0; i < 4; ++i) iv[i] = inv_rms(ssv[r0 + s4 + i]);
#pragma unroll
            for (int i2 = 0; i2 < 8; ++i2) { const int t = (tid >> 5) + i2 * 16; const f32x4 w = *(const f32x4*)(wsp + (size_t)(h * 128 + t) * 128 + s4);
                float a[4];
#pragma unroll
                for (int i = 0; i < 4; ++i) a[i] = (s4 + i <= t) ? w[i] * iv[i] : 0.f;
                u32x2 o; o.x = cvt_pk_bf16(a[0], a[1]); o.y = cvt_pk_bf16(a[2], a[3]);
                *(LAS u32x2*)(As + t * LP + s4) = o; }
        }
#pragma unroll
        for (int i2 = 0; i2 < 8; ++i2) {
            const int q = i2 * 512 + tid, s = q & 127, cc = q >> 7;
            const u32x4 v = *(const u32x4*)(z + (size_t)(r0 + s) * NBIN + DM + c0 + cc * 8);
#pragma unroll
            for (int i = 0; i < 4; ++i) { Vt[(cc * 8 + 2 * i) * LP + s] = (bf16_t)(v[i] & 0xffffu); Vt[(cc * 8 + 2 * i + 1) * LP + s] = (bf16_t)(v[i] >> 16); }
        }
        __syncthreads();
        f32x4 acc[4][4];
#pragma unroll
        for (int mi = 0; mi < 4; ++mi)
#pragma unroll
            for (int ni = 0; ni < 4; ++ni) acc[mi][ni] = (f32x4){0.f, 0.f, 0.f, 0.f};
#pragma unroll
        for (int ks = 0; ks < 4; ++ks) {
            bf16x8 a[4], b[4];
#pragma unroll
            for (int mi = 0; mi < 4; ++mi) a[mi] = *(const LAS bf16x8*)(As + (tb * 64 + mi * 16 + fr) * LP + ks * 32 + fq * 8);
#pragma unroll
            for (int ni = 0; ni < 4; ++ni) b[ni] = *(const LAS bf16x8*)(Vt + (cb * 64 + ni * 16 + fr) * LP + ks * 32 + fq * 8);
#pragma unroll
            for (int mi = 0; mi < 4; ++mi)
#pragma unroll
                for (int ni = 0; ni < 4; ++ni) acc[mi][ni] = __builtin_amdgcn_mfma_f32_16x16x32_bf16(b[ni], a[mi], acc[mi][ni], 0, 0, 0);
        }
#pragma unroll
        for (int mi = 0; mi < 4; ++mi) {
            const int t = tb * 64 + mi * 16 + fr; const float bias = bs[h * 128 + t];
#pragma unroll
            for (int ni = 0; ni < 4; ++ni) {
                const int c = cb * 64 + ni * 16 + 4 * fq;
                const f32x4 g = *(const f32x4*)(gv + c0 + c);
                bf16_t* up = z + (size_t)(r0 + t) * NBIN + c0 + c;
                const u32x2 uu = *(const u32x2*)up;
                const float o0 = bf_lo(uu.x) * (g[0] * acc[mi][ni][0] + bias), o1 = bf_hi(uu.x) * (g[1] * acc[mi][ni][1] + bias);
                const float o2 = bf_lo(uu.y) * (g[2] * acc[mi][ni][2] + bias), o3 = bf_hi(uu.y) * (g[3] * acc[mi][ni][3] + bias);
                u32x2 o; o.x = cvt_pk_bf16(o0, o1); o.y = cvt_pk_bf16(o2, o3);
                *(u32x2*)up = o;
            }
        }
        __syncthreads();
    }
}

__device__ __forceinline__ void phase_final(float* out, const float* ss, const float* g, int gw, int NGW, int lane) {
    for (int m = gw; m < MROWS; m += NGW) {
        const float inv = inv_rms(ss[m]);
        f32x4* xr = (f32x4*)(out + (size_t)m * DM) + lane; const f32x4* gr = (const f32x4*)g + lane;
#pragma unroll
        for (int j = 0; j < 8; ++j) { const f32x4 v = xr[64 * j]; const f32x4 gg = gr[64 * j]; xr[64 * j] = (v * inv) * gg; }
    }
}

__global__ void __launch_bounds__(512, 2) fwd_megakernel(Params p) {
    extern __shared__ __attribute__((aligned(16))) unsigned char lds_raw[];
    LAS unsigned char* lds = (LAS unsigned char*)lds_raw;
    cg::grid_group grid = cg::this_grid();
    const int tid = threadIdx.x, lane = tid & 63, wave = __builtin_amdgcn_readfirstlane(tid >> 6);
    const int gw = blockIdx.x * 8 + wave, NGW = gridDim.x * 8;
    unsigned char* ws = p.ws;
    float* ss = (float*)(ws + OFF_SS);
    float *ss0 = ss, *ss1 = ss + MROWS, *ss2 = ss + 2 * MROWS, *ssv = ss + 3 * MROWS, *ss3 = ss + 4 * MROWS, *ss4 = ss + 5 * MROWS;
    bf16_t* xb = (bf16_t*)(ws + OFF_XB);
    bf16_t* big = (bf16_t*)(ws + OFF_BIG);
    bf16_t* halo = (bf16_t*)(ws + OFF_HALO);
    float* out = p.out;

    volatile LAS unsigned* bst = (volatile LAS unsigned*)(lds + 131072);
    if (tid < 2) bst[tid] = 0u;
    phase0(p, lds, gw, NGW, wave, lane);
    grid.sync();
    const XcdBarrier xbar = xcd_barrier_post((unsigned*)(ws + OFF_BAR), bst);
#define GSYNC() xcd_barrier(xbar)
    { Epi<0> E{big, NAIN, ss0, nullptr, nullptr, nullptr, nullptr, nullptr};
      gemm_phase(lds, xb, DM, (const bf16_t*)(ws + OFF_W_AIN), MROWS, NAIN, DM, E); }
    GSYNC();
    phase_mixA(big, p.in[3], gw, NGW, lane);
    GSYNC();
    { Epi<3> E{nullptr, 0, nullptr, ss1, p.in[0], out, xb, nullptr};
      gemm_phase(lds, big, NAIN, (const bf16_t*)(ws + OFF_W_AOUT), MROWS, DM, DM, E); }
    GSYNC();
    { Epi<1> E{big, NUP, ss1, nullptr, nullptr, nullptr, nullptr, halo};
      gemm_phase(lds, xb, DM, (const bf16_t*)(ws + OFF_W_UP0), MROWS, NUP, DM, E); }
    GSYNC();
    phase_ffn_act(big, halo, p.in[13], p.in[14], gw, NGW, lane);
    GSYNC();
    { Epi<3> E{nullptr, 0, nullptr, ss2, out, out, xb, nullptr};
      gemm_phase(lds, big, NUP, (const bf16_t*)(ws + OFF_W_DN0), MROWS, DM, DFF, E); }
    GSYNC();
    { Epi<2> E{big, NBIN, ss2, ssv, nullptr, nullptr, nullptr, nullptr};
      gemm_phase(lds, xb, DM, (const bf16_t*)(ws + OFF_W_BIN), MROWS, NBIN, DM, E); }
    GSYNC();
    phase_sg(lds, big, p.in[8], p.in[9], p.in[7], ssv);
    GSYNC();
    { Epi<3> E{nullptr, 0, nullptr, ss3, out, out, xb, nullptr};
      gemm_phase(lds, big, NBIN, (const bf16_t*)(ws + OFF_W_BOUT), MROWS, DM, DM, E); }
    GSYNC();
    { Epi<1> E{big, NUP, ss3, nullptr, nullptr, nullptr, nullptr, halo};
      gemm_phase(lds, xb, DM, (const bf16_t*)(ws + OFF_W_UP1), MROWS, NUP, DM, E); }
    GSYNC();
    phase_ffn_act(big, halo, p.in[13] + 3 * NUP, p.in[14] + NUP, gw, NGW, lane);
    GSYNC();
    { Epi<3> E{nullptr, 0, nullptr, ss4, out, out, xb, nullptr};
      gemm_phase(lds, big, NUP, (const bf16_t*)(ws + OFF_W_DN1), MROWS, DM, DFF, E); }
    GSYNC();
    phase_final(out, ss4, p.in[16], gw, NGW, lane);
}

extern "C" void kernel_launch(void* const* d_in, const int* in_sizes, int n_in, void* d_out, int out_size, void* d_ws, size_t ws_size, hipStream_t stream) {
    static int grid_blocks = 0;
    if (grid_blocks == 0) {
        if (n_in != 17 || out_size != MROWS * DM || ws_size < WS_NEED) { fprintf(stderr, "kernel_launch: unexpected problem (n_in %d out %d ws %zu need %zu)\n", n_in, out_size, ws_size, (size_t)WS_NEED); grid_blocks = -1; return; }
        int dev = 0, cus = 0, per_cu = 0;
        hipGetDevice(&dev);
        hipDeviceGetAttribute(&cus, hipDeviceAttributeMultiprocessorCount, dev);
        if (hipFuncSetAttribute((const void*)fwd_megakernel, hipFuncAttributeMaxDynamicSharedMemorySize, LDS_BYTES) != hipSuccess) { fprintf(stderr, "kernel_launch: hipFuncSetAttribute failed\n"); grid_blocks = -1; return; }
        if (hipOccupancyMaxActiveBlocksPerMultiprocessor(&per_cu, (const void*)fwd_megakernel, 512, LDS_BYTES) != hipSuccess || per_cu < 1) { fprintf(stderr, "kernel_launch: occupancy query gave %d\n", per_cu); per_cu = 1; }
        (void)hipGetLastError();
        grid_blocks = cus * per_cu;
    }
    if (grid_blocks < 0) return;
    Params p{};
    for (int i = 0; i < 17; ++i) p.in[i] = (const float*)d_in[i];
    p.out = (float*)d_out; p.ws = (unsigned char*)d_ws;
    void* args[] = {&p};
    hipError_t e = hipLaunchCooperativeKernel((const void*)fwd_megakernel, dim3(grid_blocks), dim3(512), args, LDS_BYTES, stream);
    if (e != hipSuccess) fprintf(stderr, "cooperative launch failed: %s (grid %d)\n", hipGetErrorString(e), grid_blocks);
}
```

```cpp
#include <hip/hip_runtime.h>
#include <hip/hip_cooperative_groups.h>
#include <cstdio>
namespace cg = cooperative_groups;

#define LAS __attribute__((address_space(3)))
typedef unsigned short bf16_t;
typedef short bf16x8 __attribute__((ext_vector_type(8)));
typedef float f32x4 __attribute__((ext_vector_type(4)));
typedef unsigned u32x4 __attribute__((ext_vector_type(4)));
typedef unsigned u32x2 __attribute__((ext_vector_type(2)));

constexpr int DM = 2048, SEQ = 8192, MROWS = 16384, DFF = 5632, NUP = 11264, NAIN = 6144, NBIN = 4096;
constexpr float RMS_EPS = 1e-5f;
constexpr size_t MiB = 1u << 20;
constexpr size_t OFF_SS = 0;
constexpr size_t OFF_BAR = 512 * 1024;
constexpr size_t OFF_W_AIN = 1 * MiB;
constexpr size_t OFF_W_AOUT = OFF_W_AIN + 24 * MiB;
constexpr size_t OFF_W_UP0 = OFF_W_AOUT + 8 * MiB;
constexpr size_t OFF_W_DN0 = OFF_W_UP0 + 44 * MiB;
constexpr size_t OFF_W_BIN = OFF_W_DN0 + 22 * MiB;
constexpr size_t OFF_W_BOUT = OFF_W_BIN + 16 * MiB;
constexpr size_t OFF_W_UP1 = OFF_W_BOUT + 8 * MiB;
constexpr size_t OFF_W_DN1 = OFF_W_UP1 + 44 * MiB;
constexpr size_t OFF_XB = OFF_W_DN1 + 22 * MiB;
constexpr size_t OFF_BIG = OFF_XB + 64 * MiB;
constexpr size_t OFF_SIDE = OFF_BIG + 192 * MiB;
constexpr size_t WS_NEED = OFF_SIDE + 22 * MiB;

constexpr int LDS_BYTES = 132096;

__device__ __forceinline__ unsigned cvt_pk_bf16(float lo, float hi) { unsigned r; asm volatile("v_cvt_pk_bf16_f32 %0, %1, %2" : "=v"(r) : "v"(lo), "v"(hi)); return r; }
__device__ __forceinline__ float bf_lo(unsigned w) { return __uint_as_float(w << 16); }
__device__ __forceinline__ float bf_hi(unsigned w) { return __uint_as_float(w & 0xffff0000u); }
__device__ __forceinline__ float wave_sum(float v) {
#pragma unroll
    for (int o = 1; o < 64; o <<= 1) v += __shfl_xor(v, o);
    return v;
}
__device__ __forceinline__ float fast_rcp(float x) { return __builtin_amdgcn_rcpf(x); }
__device__ __forceinline__ float gelu_tanh(float x) {
    const float u = 0.7978845608028654f * (x + 0.044715f * x * x * x);
    return x * fast_rcp(1.0f + __builtin_amdgcn_exp2f(-2.8853900817779268f * u));
}
__device__ __forceinline__ float silu(float x) { return x * fast_rcp(1.0f + __builtin_amdgcn_exp2f(-1.4426950408889634f * x)); }
__device__ __forceinline__ float inv_rms(float ss) { return __builtin_amdgcn_rsqf(ss * (1.0f / DM) + RMS_EPS); }


#define XB_TMO      128
#define XB_XCNT(j)  (256  + 64 * (j))
#define XB_XSUB(j)  (1280 + 64 * (j))
#define XB_XGEN(j)  (2304 + 64 * (j))
#define XB_TOP      3328
#define XB_TOPGEN   3392
#define XCD_BAR_WORDS 3456
#define XB_SPIN_CAP (1u << 22)
__device__ __forceinline__ unsigned xb_ld(unsigned* p)              { return __hip_atomic_load(p, __ATOMIC_RELAXED, __HIP_MEMORY_SCOPE_AGENT); }
__device__ __forceinline__ unsigned xb_add(unsigned* p, unsigned v) { return __hip_atomic_fetch_add(p, v, __ATOMIC_RELAXED, __HIP_MEMORY_SCOPE_AGENT); }
__device__ __forceinline__ unsigned xb_xcc_id() { return (unsigned)__builtin_amdgcn_s_getreg((3 << 11) | 20) & 0xFu; }
#define XB_SPIN(cond, bar) do { unsigned _sp = 0; while (cond) { __builtin_amdgcn_s_sleep(1); \
    if ((++_sp & 255u) == 0u) { if (xb_ld(&(bar)[XB_TMO])) break; if (_sp > XB_SPIN_CAP) { atomicAdd(&(bar)[XB_TMO], 1u); break; } } } } while (0)
struct XcdBarrier { unsigned* bar; unsigned x; volatile LAS unsigned* st; };
__device__ __forceinline__ XcdBarrier xcd_barrier_post(unsigned* bar, volatile LAS unsigned* st) {
    XcdBarrier b; b.bar = bar; b.x = xb_xcc_id(); b.st = st;
    if (threadIdx.x == 0) (void)xb_add(&bar[XB_XCNT(b.x)], 1u);
    return b;
}
__device__ __forceinline__ void xcd_barrier_complete(unsigned* bar, unsigned x, unsigned& nloc, unsigned& nx) {
    const unsigned G = gridDim.x * gridDim.y * gridDim.z;
    unsigned sum, cnt, mine, sp = 0u;
    for (;;) {
        sum = 0u; cnt = 0u; mine = 0u;
#pragma unroll
        for (unsigned j = 0; j < 16; ++j) { const unsigned c = xb_ld(&bar[XB_XCNT(j)]); sum += c; cnt += (c > 0u) ? 1u : 0u; mine = (j == x) ? c : mine; }
        if (sum == G) break;
        __builtin_amdgcn_s_sleep(1);
        if ((++sp & 255u) == 0u) { if (xb_ld(&bar[XB_TMO])) break; if (sp > XB_SPIN_CAP) { atomicAdd(&bar[XB_TMO], 1u); break; } }
    }
    nloc = mine > 0u ? mine : 1u; nx = cnt > 0u ? cnt : 1u;
}
__device__ __forceinline__ void xcd_barrier(const XcdBarrier& b) {
    asm volatile("s_waitcnt vmcnt(0)" ::: "memory");
    __syncthreads();
    if (threadIdx.x == 0) {
        unsigned* bar = b.bar;
        __builtin_amdgcn_s_waitcnt(0);
        unsigned nloc = b.st[0], nx = b.st[1];
        if (nloc == 0u) { xcd_barrier_complete(bar, b.x, nloc, nx); b.st[0] = nloc; b.st[1] = nx; }
        const unsigned old = xb_add(&bar[XB_XSUB(b.x)], 1u);
        const unsigned gen = old / nloc;
        if (old + 1u == (gen + 1u) * nloc) {
            __builtin_amdgcn_fence(__ATOMIC_RELEASE, "agent");
            asm volatile("s_waitcnt vmcnt(0)" ::: "memory");
            const unsigned og = xb_add(&bar[XB_TOP], 1u);
            const unsigned tg = og / nx;
            if (og + 1u == (tg + 1u) * nx) xb_add(&bar[XB_TOPGEN], 1u);
            else XB_SPIN(xb_ld(&bar[XB_TOPGEN]) == tg, bar);
            __builtin_amdgcn_fence(__ATOMIC_ACQUIRE, "agent");
            xb_add(&bar[XB_XGEN(b.x)], 1u);
            asm volatile("s_waitcnt vmcnt(0)" ::: "memory");
        } else {
            XB_SPIN(xb_ld(&bar[XB_XGEN(b.x)]) == gen, bar);
            __builtin_amdgcn_fence(__ATOMIC_ACQUIRE, "agent");
            asm volatile("s_waitcnt vmcnt(0)" ::: "memory");
        }
    }
    __syncthreads();
}

constexpr int BM = 256, BK = 64, HALF = 128, HTB = HALF * BK * 2, NXCD = 8, WGM = 4;
__device__ __forceinline__ int lds_byte(int r, int c) { const int st = (r >> 4) * 2 + (c >> 5), rr = r & 15, cc = c & 31, ob = rr * 64 + cc * 2; return st * 1024 + (ob ^ (((ob >> 9) & 1) << 5)); }
__device__ __forceinline__ void stage_rc(int b, int& R, int& C) { const int st = b / 1024, sb = b % 1024, swz = sb ^ (((sb >> 9) & 1) << 5); R = (st >> 1) * 16 + swz / 64; C = (st & 1) * 32 + (swz % 64) / 2; }
__device__ __forceinline__ int perm32(int rho) { const int n = rho >> 4, i = rho & 15; return 8 * (i >> 2) + 4 * n + (i & 3); }

struct Unit { int pm, pn; };
struct StaticOrder {
    int nM, nN, nwg, G, c;
    __device__ void init(int M, int N, int G_, int c_) { nM = M / BM; nN = N / BM; nwg = nM * nN; G = G_; c = c_; }
    __device__ bool next(int i, Unit& u) const {
        const long L = (long)i * G + c; if (L >= nwg) return false;
        int wgid = (int)L; { const int q = nwg / NXCD, r = nwg % NXCD, xcd = wgid % NXCD, off = wgid / NXCD; wgid = (xcd < r ? xcd * (q + 1) : r * (q + 1) + (xcd - r) * q) + off; }
        const int nig = WGM * nN, gid = wgid / nig, fm = gid * WGM, gsz = (nM - fm) < WGM ? (nM - fm) : WGM;
        u.pm = fm + ((wgid % nig) % gsz); u.pn = (wgid % nig) / gsz; return true;
    }
};

template <int MODE> struct Epi {
    bf16_t* O; int ldo; const float* ss_in; float* ss_out; const float* base; float* outf; bf16_t* xb; bf16_t* halo;
    __device__ __forceinline__ void operator()(const f32x4 (&acc)[2][2][4][2], const Unit& u, int wr, int wc, int fr, int fq) const {
        const int row0 = u.pm * BM + wr * 64 + fr, col0 = u.pn * BM + wc * 32 + 8 * fq;
#pragma unroll
        for (int ai = 0; ai < 2; ++ai)
#pragma unroll
            for (int m = 0; m < 4; ++m) {
                const int row = row0 + ai * HALF + m * 16;
                if (MODE != 3) {
                    const float inv = inv_rms(ss_in[row]);
                    float sq = 0.f;
#pragma unroll
                    for (int bj = 0; bj < 2; ++bj) {
                        f32x4 v0 = acc[ai][bj][m][0] * inv, v1 = acc[ai][bj][m][1] * inv;
                        if (MODE == 2) {
#pragma unroll
                            for (int j = 0; j < 4; ++j) { v0[j] = gelu_tanh(v0[j]); v1[j] = gelu_tanh(v1[j]); sq += v0[j] * v0[j] + v1[j] * v1[j]; }
                        }
                        u32x4 w; w.x = cvt_pk_bf16(v0[0], v0[1]); w.y = cvt_pk_bf16(v0[2], v0[3]); w.z = cvt_pk_bf16(v1[0], v1[1]); w.w = cvt_pk_bf16(v1[2], v1[3]);
                        *(u32x4*)(O + (size_t)row * ldo + col0 + bj * HALF) = w;
                    }
                    if (MODE == 2) {
                        if (u.pn >= 8) { sq += __shfl_xor(sq, 16); sq += __shfl_xor(sq, 32); if (fq == 0) atomicAdd(ss_out + row, sq); }
                    }
                } else {
                    float sq = 0.f;
#pragma unroll
                    for (int bj = 0; bj < 2; ++bj) {
                        const size_t off = (size_t)row * DM + col0 + bj * HALF;
                        const f32x4 b0 = *(const f32x4*)(base + off), b1 = *(const f32x4*)(base + off + 4);
                        const f32x4 v0 = acc[ai][bj][m][0] + b0, v1 = acc[ai][bj][m][1] + b1;
                        *(f32x4*)(outf + off) = v0; *(f32x4*)(outf + off + 4) = v1;
                        u32x4 w; w.x = cvt_pk_bf16(v0[0], v0[1]); w.y = cvt_pk_bf16(v0[2], v0[3]); w.z = cvt_pk_bf16(v1[0], v1[1]); w.w = cvt_pk_bf16(v1[2], v1[3]);
                        *(u32x4*)(xb + off) = w;
#pragma unroll
                        for (int j = 0; j < 4; ++j) sq += v0[j] * v0[j] + v1[j] * v1[j];
                    }
                    sq += __shfl_xor(sq, 16); sq += __shfl_xor(sq, 32);
                    if (fq == 0) atomicAdd(ss_out + row, sq);
                }
            }
    }
};


__device__ __forceinline__ float dpp_ror1(float v) { return __int_as_float(__builtin_amdgcn_update_dpp(0, __float_as_int(v), 0x121, 0xf, 0xf, false)); }
__device__ __forceinline__ float dpp_ror2(float v) { return __int_as_float(__builtin_amdgcn_update_dpp(0, __float_as_int(v), 0x122, 0xf, 0xf, false)); }
struct EpiFfn {
    bf16_t* act; const float* ss_in; const float* cw; const float* cb; float* side;
    __device__ __forceinline__ void operator()(const f32x4 (&acc)[2][2][4][2], const Unit& u, int wr, int wc, int fr, int fq) const {
        const int rbase = u.pm * BM + wr * 128 + fr, jg0 = u.pn * 128 + wc * 32 + 8 * fq, chunk = u.pm * 2 + wr;
        u32x2 P0[8];
#pragma unroll
        for (int n = 0; n < 2; ++n) {
            const int jg = jg0 + 4 * n;
            const f32x4 w0g = *(const f32x4*)(cw + jg), w1g = *(const f32x4*)(cw + NUP + jg), w2g = *(const f32x4*)(cw + 2 * NUP + jg), bg = *(const f32x4*)(cb + jg);
            const f32x4 w0a = *(const f32x4*)(cw + DFF + jg), w1a = *(const f32x4*)(cw + NUP + DFF + jg), w2a = *(const f32x4*)(cw + 2 * NUP + DFF + jg), ba = *(const f32x4*)(cb + DFF + jg);
            f32x4 pg = {0.f, 0.f, 0.f, 0.f}, pa = pg;
#pragma unroll
            for (int k = 0; k < 8; ++k) {
                const int ai = k >> 2, m = k & 3;
                const float inv = inv_rms(ss_in[rbase + k * 16]);
                const f32x4 ug = acc[ai][0][m][n] * inv, ua = acc[ai][1][m][n] * inv;
                if (k == 0) { if (fr < 2) { float* sp = side + (size_t)(chunk * 4 + fr) * NUP + jg; *(f32x4*)sp = ug; *(f32x4*)(sp + DFF) = ua; } }
                if (k == 7) { if (fr >= 14) { float* sp = side + (size_t)(chunk * 4 + fr - 12) * NUP + jg; *(f32x4*)sp = ug; *(f32x4*)(sp + DFF) = ua; } }
                float o[4];
#pragma unroll
                for (int e = 0; e < 4; ++e) {
                    const float p1g = dpp_ror1(fr == 15 ? pg[e] : ug[e]), p2g = dpp_ror2(fr >= 14 ? pg[e] : ug[e]);
                    const float p1a = dpp_ror1(fr == 15 ? pa[e] : ua[e]), p2a = dpp_ror2(fr >= 14 ? pa[e] : ua[e]);
                    const float cgv = w0g[e] * p2g + w1g[e] * p1g + w2g[e] * ug[e] + bg[e];
                    const float cav = w0a[e] * p2a + w1a[e] * p1a + w2a[e] * ua[e] + ba[e];
                    o[e] = silu(cgv) * cav;
                }
                u32x2 pk; pk.x = cvt_pk_bf16(o[0], o[1]); pk.y = cvt_pk_bf16(o[2], o[3]);
                if (n == 0) P0[k] = pk;
                else if (k > 0 || fr >= 2) { u32x4 w; w.x = P0[k].x; w.y = P0[k].y; w.z = pk.x; w.w = pk.y; *(u32x4*)(act + (size_t)(rbase + k * 16) * DFF + jg0) = w; }
                pg = ug; pa = ua;
                asm volatile("" ::: "memory");
            }
        }
    }
};
__device__ __forceinline__ void phase_ffn_fix(bf16_t* act, const float* side, const float* cw, const float* cb, int gtid, int NT) {
    for (int it = gtid; it < 128 * (DFF / 4); it += NT) {
        const int c = it / (DFF / 4), j = (it - c * (DFF / 4)) * 4;
        const float* s = side + (size_t)(c * 4) * NUP + j;
        const f32x4 g0 = *(const f32x4*)s, g1 = *(const f32x4*)(s + NUP), a0 = *(const f32x4*)(s + DFF), a1 = *(const f32x4*)(s + NUP + DFF);
        f32x4 gA = {0.f, 0.f, 0.f, 0.f}, gB = gA, aA = gA, aB = gA;
        if (c & 63) { const float* sp = s - 2 * NUP; gA = *(const f32x4*)sp; gB = *(const f32x4*)(sp + NUP); aA = *(const f32x4*)(sp + DFF); aB = *(const f32x4*)(sp + NUP + DFF); }
        const f32x4 w0g = *(const f32x4*)(cw + j), w1g = *(const f32x4*)(cw + NUP + j), w2g = *(const f32x4*)(cw + 2 * NUP + j), bg = *(const f32x4*)(cb + j);
        const f32x4 w0a = *(const f32x4*)(cw + DFF + j), w1a = *(const f32x4*)(cw + NUP + DFF + j), w2a = *(const f32x4*)(cw + 2 * NUP + DFF + j), ba = *(const f32x4*)(cb + DFF + j);
        float o0[4], o1[4];
#pragma unroll
        for (int e = 0; e < 4; ++e) {
            o0[e] = silu(w0g[e] * gA[e] + w1g[e] * gB[e] + w2g[e] * g0[e] + bg[e]) * (w0a[e] * aA[e] + w1a[e] * aB[e] + w2a[e] * a0[e] + ba[e]);
            o1[e] = silu(w0g[e] * gB[e] + w1g[e] * g0[e] + w2g[e] * g1[e] + bg[e]) * (w0a[e] * aB[e] + w1a[e] * a0[e] + w2a[e] * a1[e] + ba[e]);
        }
        u32x2 p0, p1; p0.x = cvt_pk_bf16(o0[0], o0[1]); p0.y = cvt_pk_bf16(o0[2], o0[3]); p1.x = cvt_pk_bf16(o1[0], o1[1]); p1.y = cvt_pk_bf16(o1[2], o1[3]);
        *(u32x2*)(act + (size_t)(c * 128) * DFF + j) = p0; *(u32x2*)(act + (size_t)(c * 128 + 1) * DFF + j) = p1;
    }
}

template <class EpiT, bool FFN = false>
__device__ __forceinline__ void gemm_phase(LAS unsigned char* lds, const bf16_t* A, int lda, const bf16_t* Bt, int Mg, int N, int K, const EpiT& E) {
    const int tid = threadIdx.x, wid = __builtin_amdgcn_readfirstlane(tid >> 6), lane = tid & 63, wr = wid >> 2, wc = wid & 3, fr = lane & 15, fq = lane >> 4;
    const int nt = K / BK;
    StaticOrder S; S.init(Mg, N, (int)gridDim.x, (int)blockIdx.x);
    unsigned voffA[2], voffB[2];
#pragma unroll
    for (int i = 0; i < 2; ++i) { int R, C; stage_rc(tid * 16 + i * 8192, R, C); const int Rb = (R & ~31) + perm32(R & 31);
        const int Ra = FFN ? ((R >> 6) * 128 + (R & 63)) : R;
        voffA[i] = (unsigned)(Ra * lda + C) * 2u; voffB[i] = (unsigned)(Rb * K + C) * 2u; }
    const size_t kstep = (size_t)(BK * 2);
    const size_t hstepA = (size_t)(FFN ? 64 : HALF) * lda * 2, hstepB = (size_t)(FFN ? DFF : HALF) * K * 2;
    const size_t tstepA = (size_t)BM * lda * 2, tstepB = (size_t)(FFN ? HALF : BM) * K * 2;
    const unsigned ldsw = (unsigned)wid * 1024u;
    const int aoff = lds_byte(wr * 64 + fr, fq * 8), boff = lds_byte(wc * 32 + fr, fq * 8);
#define PG8_SA(b, h) (((b) * 2 + (h)) * HTB)
#define PG8_SB(b, h) ((4 + (b) * 2 + (h)) * HTB)
#define PG8_STAGE(bufoff, gbase, voff) do { _Pragma("unroll") for (int _i = 0; _i < 2; ++_i) \
        __builtin_amdgcn_global_load_lds((const unsigned*)((const char*)(gbase) + (voff)[_i]), (LAS unsigned*)(lds + (bufoff) + ldsw + _i * 8192), 16, 0, 0); } while (0)
#define PG8_LDA(dst, b, h) do { _Pragma("unroll") for (int m = 0; m < 4; ++m) _Pragma("unroll") for (int k = 0; k < 2; ++k) dst[m][k] = *(const LAS bf16x8*)(lds + PG8_SA(b, h) + aoff + m * 2048 + k * 1024); } while (0)
#define PG8_LDB(dst, b, h) do { _Pragma("unroll") for (int n = 0; n < 2; ++n) _Pragma("unroll") for (int k = 0; k < 2; ++k) dst[n][k] = *(const LAS bf16x8*)(lds + PG8_SB(b, h) + boff + n * 2048 + k * 1024); } while (0)
#define PG8_MMA(ai, bj, At, Bt_) do { __builtin_amdgcn_s_setprio(1); _Pragma("unroll") for (int m = 0; m < 4; ++m) _Pragma("unroll") for (int n = 0; n < 2; ++n) _Pragma("unroll") for (int k = 0; k < 2; ++k) \
        acc[ai][bj][m][n] = __builtin_amdgcn_mfma_f32_16x16x32_bf16(Bt_[n][k], At[m][k], acc[ai][bj][m][n], 0, 0, 0); __builtin_amdgcn_s_setprio(0); } while (0)
#define PG8_WAIT_V(n) asm volatile("s_waitcnt vmcnt(" #n ")" ::: "memory")
#define PG8_WAIT_L(n) asm volatile("s_waitcnt lgkmcnt(" #n ")" ::: "memory")
#define PG8_BAR __builtin_amdgcn_s_barrier()
#define PG8_SCHED __builtin_amdgcn_sched_barrier(0)
    Unit cur, nxt; int ui = 0;
    if (!S.next(0, cur)) return;
    f32x4 acc[2][2][4][2];
#pragma unroll
    for (int a = 0; a < 2; ++a)
#pragma unroll
        for (int b = 0; b < 2; ++b)
#pragma unroll
            for (int m = 0; m < 4; ++m)
#pragma unroll
                for (int n = 0; n < 2; ++n) acc[a][b][m][n] = (f32x4){0.f, 0.f, 0.f, 0.f};
    bf16x8 At[4][2], B0[2][2], B1[2][2];
    const char* cA = (const char*)A + (size_t)cur.pm * tstepA; const char* cB = (const char*)Bt + (size_t)cur.pn * tstepB;
    PG8_STAGE(PG8_SB(0, 0), cB, voffB); PG8_STAGE(PG8_SA(0, 0), cA, voffA); PG8_STAGE(PG8_SB(0, 1), cB + hstepB, voffB); PG8_STAGE(PG8_SA(0, 1), cA + hstepA, voffA);
    if (wr == 1) PG8_BAR;
    PG8_WAIT_V(4); PG8_BAR;
    PG8_STAGE(PG8_SB(1, 0), cB + kstep, voffB); PG8_STAGE(PG8_SA(1, 0), cA + kstep, voffA); PG8_STAGE(PG8_SB(1, 1), cB + hstepB + kstep, voffB);
    PG8_WAIT_V(6); PG8_BAR;
    for (;;) {
        const bool has_next = S.next(ui + 1, nxt);
        const char* nA = has_next ? (const char*)A + (size_t)nxt.pm * tstepA : cA; const char* nB = has_next ? (const char*)Bt + (size_t)nxt.pn * tstepB : cB;
        for (int t = 0; t < nt; t += 2) {
            const bool last = (t == nt - 2);
            const char* a1 = cA + (size_t)(t + 1) * kstep;
            const char* a2 = last ? nA : cA + (size_t)(t + 2) * kstep; const char* b2 = last ? nB : cB + (size_t)(t + 2) * kstep;
            const char* a3 = a2 + kstep; const char* b3 = b2 + kstep;
            PG8_LDB(B0, 0, 0); PG8_SCHED; PG8_LDA(At, 0, 0); PG8_STAGE(PG8_SA(1, 1), a1 + hstepA, voffA);
            PG8_WAIT_L(8); PG8_BAR; PG8_WAIT_L(0); PG8_MMA(0, 0, At, B0); PG8_BAR; PG8_SCHED;
            PG8_LDB(B1, 0, 1); PG8_STAGE(PG8_SB(0, 0), b2, voffB);
            PG8_BAR; PG8_WAIT_L(0); PG8_MMA(0, 1, At, B1); PG8_BAR;
            PG8_LDA(At, 0, 1); PG8_STAGE(PG8_SA(0, 0), a2, voffA);
            PG8_BAR; PG8_WAIT_L(0); PG8_MMA(1, 0, At, B0); PG8_BAR; PG8_SCHED;
            PG8_STAGE(PG8_SB(0, 1), b2 + hstepB, voffB);
            PG8_WAIT_V(6); PG8_BAR; PG8_MMA(1, 1, At, B1); PG8_BAR;
            PG8_LDB(B0, 1, 0); PG8_SCHED; PG8_LDA(At, 1, 0); PG8_STAGE(PG8_SA(0, 1), a2 + hstepA, voffA);
            PG8_WAIT_L(8); PG8_BAR; PG8_WAIT_L(0); PG8_MMA(0, 0, At, B0); PG8_BAR; PG8_SCHED;
            PG8_LDB(B1, 1, 1); PG8_STAGE(PG8_SB(1, 0), b3, voffB);
            PG8_BAR; PG8_WAIT_L(0); PG8_MMA(0, 1, At, B1); PG8_BAR;
            PG8_LDA(At, 1, 1); PG8_STAGE(PG8_SA(1, 0), a3, voffA);
            PG8_BAR; PG8_WAIT_L(0); PG8_MMA(1, 0, At, B0); PG8_BAR; PG8_SCHED;
            PG8_STAGE(PG8_SB(1, 1), b3 + hstepB, voffB);
            PG8_WAIT_V(6); PG8_BAR; PG8_MMA(1, 1, At, B1); PG8_BAR;
        }
        E(acc, cur, wr, wc, fr, fq);
        if (!has_next) break;
#pragma unroll
        for (int a = 0; a < 2; ++a)
#pragma unroll
            for (int b = 0; b < 2; ++b)
#pragma unroll
                for (int m = 0; m < 4; ++m)
#pragma unroll
                    for (int n = 0; n < 2; ++n) acc[a][b][m][n] = (f32x4){0.f, 0.f, 0.f, 0.f};
        cur = nxt; cA = nA; cB = nB; ++ui;
    }
    PG8_WAIT_V(0);
    if (wr == 0) PG8_BAR;
    PG8_BAR;
#undef PG8_SA
#undef PG8_SB
#undef PG8_STAGE
#undef PG8_LDA
#undef PG8_LDB
#undef PG8_MMA
#undef PG8_WAIT_V
#undef PG8_WAIT_L
#undef PG8_BAR
#undef PG8_SCHED
}

__device__ __forceinline__ void p0_transpose_item(const float* W, int K, int N, bf16_t* WT, const float* gain, int item, int lane) {
    const int nblk = N / 64, kb = item / nblk, nb = item - kb * nblk, k0 = 64 * kb, n0 = 64 * nb;
    const float* src = W + (size_t)k0 * N + n0 + lane;
    float v[64];
#pragma unroll
    for (int i = 0; i < 64; ++i) v[i] = src[(size_t)i * N];
    if (gain) {
#pragma unroll
        for (int i = 0; i < 64; ++i) v[i] *= gain[k0 + i];
    }
    bf16_t* dst = WT + (size_t)(n0 + lane) * K + k0;
#pragma unroll
    for (int c = 0; c < 8; ++c) {
        u32x4 o; o.x = cvt_pk_bf16(v[8 * c], v[8 * c + 1]); o.y = cvt_pk_bf16(v[8 * c + 2], v[8 * c + 3]); o.z = cvt_pk_bf16(v[8 * c + 4], v[8 * c + 5]); o.w = cvt_pk_bf16(v[8 * c + 6], v[8 * c + 7]);
        *(u32x4*)(dst + 8 * c) = o;
    }
}

struct Params { const float* in[17]; float* out; unsigned char* ws; };

__device__ __forceinline__ void phase0(const Params& p, LAS unsigned char* lds, int gw, int NGW, int wave, int lane) {
    unsigned char* ws = p.ws;
    constexpr int I_AIN = (DM / 64) * (NAIN / 64), I_SQ = (DM / 64) * (DM / 64), I_UP = (DM / 64) * (NUP / 64), I_DN = (DFF / 64) * (DM / 64), I_BIN = (DM / 64) * (NBIN / 64);
    constexpr int NITEMS = I_AIN + 2 * I_SQ + 2 * I_UP + 2 * I_DN + I_BIN;
    for (int it = gw; it < NITEMS; it += NGW) {
        int r = it;
        if (r < I_AIN) { p0_transpose_item(p.in[2], DM, NAIN, (bf16_t*)(ws + OFF_W_AIN), p.in[1], r, lane); continue; } r -= I_AIN;
        if (r < I_SQ) { p0_transpose_item(p.in[4], DM, DM, (bf16_t*)(ws + OFF_W_AOUT), nullptr, r, lane); continue; } r -= I_SQ;
        if (r < I_UP) { p0_transpose_item(p.in[12], DM, NUP, (bf16_t*)(ws + OFF_W_UP0), p.in[11], r, lane); continue; } r -= I_UP;
        if (r < I_DN) { p0_transpose_item(p.in[15], DFF, DM, (bf16_t*)(ws + OFF_W_DN0), nullptr, r, lane); continue; } r -= I_DN;
        if (r < I_BIN) { p0_transpose_item(p.in[6], DM, NBIN, (bf16_t*)(ws + OFF_W_BIN), p.in[5], r, lane); continue; } r -= I_BIN;
        if (r < I_SQ) { p0_transpose_item(p.in[10], DM, DM, (bf16_t*)(ws + OFF_W_BOUT), nullptr, r, lane); continue; } r -= I_SQ;
        if (r < I_UP) { p0_transpose_item(p.in[12] + (size_t)DM * NUP, DM, NUP, (bf16_t*)(ws + OFF_W_UP1), p.in[11] + DM, r, lane); continue; } r -= I_UP;
        p0_transpose_item(p.in[15] + (size_t)DFF * DM, DFF, DM, (bf16_t*)(ws + OFF_W_DN1), nullptr, r, lane);
    }
    float* ss = (float*)(ws + OFF_SS);
    bf16_t* xb = (bf16_t*)(ws + OFF_XB);
    for (int m = gw; m < MROWS; m += NGW) {
        const f32x4* xr = (const f32x4*)(p.in[0] + (size_t)m * DM) + lane;
        f32x4 v[8]; float s = 0.f;
#pragma unroll
        for (int j = 0; j < 8; ++j) { v[j] = xr[64 * j]; s += (v[j][0] * v[j][0] + v[j][1] * v[j][1]) + (v[j][2] * v[j][2] + v[j][3] * v[j][3]); }
        s = wave_sum(s);
        u32x2* o = (u32x2*)(xb + (size_t)m * DM) + lane;
#pragma unroll
        for (int j = 0; j < 8; ++j) { u32x2 w; w.x = cvt_pk_bf16(v[j][0], v[j][1]); w.y = cvt_pk_bf16(v[j][2], v[j][3]); o[64 * j] = w; }
        if (lane == 0) ss[m] = s;
    }
    if (gw < 8) { unsigned* bw = (unsigned*)(ws + OFF_BAR); for (int i = gw * 64 + lane; i < 3456; i += 512) bw[i] = 0u; }
    for (int i = gw * 64 + lane; i < 5 * MROWS; i += NGW * 64) ss[MROWS + i] = 0.f;
}

__device__ __forceinline__ void phase_mixA(bf16_t* bcx, const float* cw, int gw, int NGW, int lane) {
    for (int it = gw; it < (MROWS / 32) * 4; it += NGW) {
        const int seg = it >> 2, cb = it & 3, t0 = seg * 32, j = cb * 512 + lane * 8;
        float w0[8], w1[8], w2[8], pm2[8], pm1[8];
#pragma unroll
        for (int q = 0; q < 2; ++q) { const f32x4 a = *(const f32x4*)(cw + j + 4 * q), b = *(const f32x4*)(cw + DM + j + 4 * q), c = *(const f32x4*)(cw + 2 * DM + j + 4 * q);
#pragma unroll
            for (int e = 0; e < 4; ++e) { w0[4 * q + e] = a[e]; w1[4 * q + e] = b[e]; w2[4 * q + e] = c[e]; } }
        if ((t0 & (SEQ - 1)) == 0) {
#pragma unroll
            for (int e = 0; e < 8; ++e) { pm2[e] = 0.f; pm1[e] = 0.f; }
        } else {
            const bf16_t* r2 = bcx + (size_t)(t0 - 2) * NAIN + j; const bf16_t* r1 = bcx + (size_t)(t0 - 1) * NAIN + j;
            const u32x4 c2 = *(const u32x4*)(r2 + DM), x2 = *(const u32x4*)(r2 + 2 * DM), c1 = *(const u32x4*)(r1 + DM), x1 = *(const u32x4*)(r1 + 2 * DM);
#pragma unroll
            for (int e = 0; e < 4; ++e) { pm2[2 * e] = bf_lo(c2[e]) * bf_lo(x2[e]); pm2[2 * e + 1] = bf_hi(c2[e]) * bf_hi(x2[e]); pm1[2 * e] = bf_lo(c1[e]) * bf_lo(x1[e]); pm1[2 * e + 1] = bf_hi(c1[e]) * bf_hi(x1[e]); }
        }
#pragma unroll 4
        for (int r = 0; r < 32; ++r) {
            bf16_t* rp = bcx + (size_t)(t0 + r) * NAIN + j;
            const u32x4 gb = *(const u32x4*)rp, gc = *(const u32x4*)(rp + DM), xs = *(const u32x4*)(rp + 2 * DM);
            float y[8];
#pragma unroll
            for (int e = 0; e < 4; ++e) {
                const float p0 = bf_lo(gc[e]) * bf_lo(xs[e]), p1 = bf_hi(gc[e]) * bf_hi(xs[e]);
                y[2 * e] = bf_lo(gb[e]) * (w0[2 * e] * pm2[2 * e] + w1[2 * e] * pm1[2 * e] + w2[2 * e] * p0);
                y[2 * e + 1] = bf_hi(gb[e]) * (w0[2 * e + 1] * pm2[2 * e + 1] + w1[2 * e + 1] * pm1[2 * e + 1] + w2[2 * e + 1] * p1);
                pm2[2 * e] = pm1[2 * e]; pm2[2 * e + 1] = pm1[2 * e + 1]; pm1[2 * e] = p0; pm1[2 * e + 1] = p1;
            }
            u32x4 w; w.x = cvt_pk_bf16(y[0], y[1]); w.y = cvt_pk_bf16(y[2], y[3]); w.z = cvt_pk_bf16(y[4], y[5]); w.w = cvt_pk_bf16(y[6], y[7]);
            *(u32x4*)rp = w;
        }
    }
}

__device__ __forceinline__ void phase_sg(LAS unsigned char* lds, bf16_t* z, const float* wsp, const float* bs, const float* gv, const float* ssv) {
    constexpr int LP = 136;
    LAS bf16_t* As = (LAS bf16_t*)lds;
    LAS bf16_t* Vt = (LAS bf16_t*)(lds + 128 * LP * 2);
    const int tid = threadIdx.x, wid = tid >> 6, lane = tid & 63, fr = lane & 15, fq = lane >> 4, tb = wid >> 2, cb = wid & 3;
    for (int it = blockIdx.x; it < (MROWS / 128) * 8; it += gridDim.x) {
        const int n = it >> 3, h = it & 7, r0 = n * 128, c0 = h * 256;
        {
            const int s4 = (tid & 31) * 4; float iv[4];
#pragma unroll
            for (int i = 0; i < 4; ++i) iv[i] = inv_rms(ssv[r0 + s4 + i]);
#pragma unroll
            for (int i2 = 0; i2 < 8; ++i2) { const int t = (tid >> 5) + i2 * 16; const f32x4 w = *(const f32x4*)(wsp + (size_t)(h * 128 + t) * 128 + s4);
                float a[4];
#pragma unroll
                for (int i = 0; i < 4; ++i) a[i] = (s4 + i <= t) ? w[i] * iv[i] : 0.f;
                u32x2 o; o.x = cvt_pk_bf16(a[0], a[1]); o.y = cvt_pk_bf16(a[2], a[3]);
                *(LAS u32x2*)(As + t * LP + s4) = o; }
        }
#pragma unroll
        for (int i2 = 0; i2 < 8; ++i2) {
            const int q = i2 * 512 + tid, s = q & 127, cc = q >> 7;
            const u32x4 v = *(const u32x4*)(z + (size_t)(r0 + s) * NBIN + DM + c0 + cc * 8);
#pragma unroll
            for (int i = 0; i < 4; ++i) { Vt[(cc * 8 + 2 * i) * LP + s] = (bf16_t)(v[i] & 0xffffu); Vt[(cc * 8 + 2 * i + 1) * LP + s] = (bf16_t)(v[i] >> 16); }
        }
        __syncthreads();
        f32x4 acc[4][4];
#pragma unroll
        for (int mi = 0; mi < 4; ++mi)
#pragma unroll
            for (int ni = 0; ni < 4; ++ni) acc[mi][ni] = (f32x4){0.f, 0.f, 0.f, 0.f};
#pragma unroll
        for (int ks = 0; ks < 4; ++ks) {
            bf16x8 a[4], b[4];
#pragma unroll
            for (int mi = 0; mi < 4; ++mi) a[mi] = *(const LAS bf16x8*)(As + (tb * 64 + mi * 16 + fr) * LP + ks * 32 + fq * 8);
#pragma unroll
            for (int ni = 0; ni < 4; ++ni) b[ni] = *(const LAS bf16x8*)(Vt + (cb * 64 + ni * 16 + fr) * LP + ks * 32 + fq * 8);
#pragma unroll
            for (int mi = 0; mi < 4; ++mi)
#pragma unroll
                for (int ni = 0; ni < 4; ++ni) acc[mi][ni] = __builtin_amdgcn_mfma_f32_16x16x32_bf16(b[ni], a[mi], acc[mi][ni], 0, 0, 0);
        }
#pragma unroll
        for (int mi = 0; mi < 4; ++mi) {
            const int t = tb * 64 + mi * 16 + fr; const float bias = bs[h * 128 + t];
#pragma unroll
            for (int ni = 0; ni < 4; ++ni) {
                const int c = cb * 64 + ni * 16 + 4 * fq;
                const f32x4 g = *(const f32x4*)(gv + c0 + c);
                bf16_t* up = z + (size_t)(r0 + t) * NBIN + c0 + c;
                const u32x2 uu = *(const u32x2*)up;
                const float o0 = bf_lo(uu.x) * (g[0] * acc[mi][ni][0] + bias), o1 = bf_hi(uu.x) * (g[1] * acc[mi][ni][1] + bias);
                const float o2 = bf_lo(uu.y) * (g[2] * acc[mi][ni][2] + bias), o3 = bf_hi(uu.y) * (g[3] * acc[mi][ni][3] + bias);
                u32x2 o; o.x = cvt_pk_bf16(o0, o1); o.y = cvt_pk_bf16(o2, o3);
                *(u32x2*)up = o;
            }
        }
        __syncthreads();
    }
}

__device__ __forceinline__ void phase_final(float* out, const float* ss, const float* g, int gw, int NGW, int lane) {
    for (int m = gw; m < MROWS; m += NGW) {
        const float inv = inv_rms(ss[m]);
        f32x4* xr = (f32x4*)(out + (size_t)m * DM) + lane; const f32x4* gr = (const f32x4*)g + lane;
#pragma unroll
        for (int j = 0; j < 8; ++j) { const f32x4 v = xr[64 * j]; const f32x4 gg = gr[64 * j]; xr[64 * j] = (v * inv) * gg; }
    }
}

__global__ void __launch_bounds__(512, 2) fwd_megakernel(Params p) {
    extern __shared__ __attribute__((aligned(16))) unsigned char lds_raw[];
    LAS unsigned char* lds = (LAS unsigned char*)lds_raw;
    cg::grid_group grid = cg::this_grid();
    const int tid = threadIdx.x, lane = tid & 63, wave = __builtin_amdgcn_readfirstlane(tid >> 6);
    const int gw = blockIdx.x * 8 + wave, NGW = gridDim.x * 8;
    unsigned char* ws = p.ws;
    float* ss = (float*)(ws + OFF_SS);
    float *ss0 = ss, *ss1 = ss + MROWS, *ss2 = ss + 2 * MROWS, *ssv = ss + 3 * MROWS, *ss3 = ss + 4 * MROWS, *ss4 = ss + 5 * MROWS;
    bf16_t* xb = (bf16_t*)(ws + OFF_XB);
    bf16_t* big = (bf16_t*)(ws + OFF_BIG);
    float* side = (float*)(ws + OFF_SIDE);
    float* out = p.out;

    volatile LAS unsigned* bst = (volatile LAS unsigned*)(lds + 131072);
    if (tid < 2) bst[tid] = 0u;
    phase0(p, lds, gw, NGW, wave, lane);
    grid.sync();
    const XcdBarrier xbar = xcd_barrier_post((unsigned*)(ws + OFF_BAR), bst);
#define GSYNC() xcd_barrier(xbar)
    { Epi<0> E{big, NAIN, ss0, nullptr, nullptr, nullptr, nullptr, nullptr};
      gemm_phase(lds, xb, DM, (const bf16_t*)(ws + OFF_W_AIN), MROWS, NAIN, DM, E); }
    GSYNC();
    phase_mixA(big, p.in[3], gw, NGW, lane);
    GSYNC();
    { Epi<3> E{nullptr, 0, nullptr, ss1, p.in[0], out, xb, nullptr};
      gemm_phase(lds, big, NAIN, (const bf16_t*)(ws + OFF_W_AOUT), MROWS, DM, DM, E); }
    GSYNC();
    { EpiFfn E{big, ss1, p.in[13], p.in[14], side};
      gemm_phase<EpiFfn, true>(lds, xb, DM, (const bf16_t*)(ws + OFF_W_UP0), MROWS, NUP, DM, E); }
    GSYNC();
    phase_ffn_fix(big, side, p.in[13], p.in[14], blockIdx.x * 512 + tid, gridDim.x * 512);
    GSYNC();
    { Epi<3> E{nullptr, 0, nullptr, ss2, out, out, xb, nullptr};
      gemm_phase(lds, big, DFF, (const bf16_t*)(ws + OFF_W_DN0), MROWS, DM, DFF, E); }
    GSYNC();
    { Epi<2> E{big, NBIN, ss2, ssv, nullptr, nullptr, nullptr, nullptr};
      gemm_phase(lds, xb, DM, (const bf16_t*)(ws + OFF_W_BIN), MROWS, NBIN, DM, E); }
    GSYNC();
    phase_sg(lds, big, p.in[8], p.in[9], p.in[7], ssv);
    GSYNC();
    { Epi<3> E{nullptr, 0, nullptr, ss3, out, out, xb, nullptr};
      gemm_phase(lds, big, NBIN, (const bf16_t*)(ws + OFF_W_BOUT), MROWS, DM, DM, E); }
    GSYNC();
    { EpiFfn E{big, ss3, p.in[13] + 3 * NUP, p.in[14] + NUP, side};
      gemm_phase<EpiFfn, true>(lds, xb, DM, (const bf16_t*)(ws + OFF_W_UP1), MROWS, NUP, DM, E); }
    GSYNC();
    phase_ffn_fix(big, side, p.in[13] + 3 * NUP, p.in[14] + NUP, blockIdx.x * 512 + tid, gridDim.x * 512);
    GSYNC();
    { Epi<3> E{nullptr, 0, nullptr, ss4, out, out, xb, nullptr};
      gemm_phase(lds, big, DFF, (const bf16_t*)(ws + OFF_W_DN1), MROWS, DM, DFF, E); }
    GSYNC();
    phase_final(out, ss4, p.in[16], gw, NGW, lane);
}

extern "C" void kernel_launch(void* const* d_in, const int* in_sizes, int n_in, void* d_out, int out_size, void* d_ws, size_t ws_size, hipStream_t stream) {
    static int grid_blocks = 0;
    if (grid_blocks == 0) {
        if (n_in != 17 || out_size != MROWS * DM || ws_size < WS_NEED) { fprintf(stderr, "kernel_launch: unexpected problem (n_in %d out %d ws %zu need %zu)\n", n_in, out_size, ws_size, (size_t)WS_NEED); grid_blocks = -1; return; }
        int dev = 0, cus = 0, per_cu = 0;
        hipGetDevice(&dev);
        hipDeviceGetAttribute(&cus, hipDeviceAttributeMultiprocessorCount, dev);
        if (hipFuncSetAttribute((const void*)fwd_megakernel, hipFuncAttributeMaxDynamicSharedMemorySize, LDS_BYTES) != hipSuccess) { fprintf(stderr, "kernel_launch: hipFuncSetAttribute failed\n"); grid_blocks = -1; return; }
        if (hipOccupancyMaxActiveBlocksPerMultiprocessor(&per_cu, (const void*)fwd_megakernel, 512, LDS_BYTES) != hipSuccess || per_cu < 1) { fprintf(stderr, "kernel_launch: occupancy query gave %d\n", per_cu); per_cu = 1; }
        (void)hipGetLastError();
        grid_blocks = cus * per_cu;
    }
    if (grid_blocks < 0) return;
    Params p{};
    for (int i = 0; i < 17; ++i) p.in[i] = (const float*)d_in[i];
    p.out = (float*)d_out; p.ws = (unsigned char*)d_ws;
    void* args[] = {&p};
    hipError_t e = hipLaunchCooperativeKernel((const void*)fwd_megakernel, dim3(grid_blocks), dim3(512), args, LDS_BYTES, stream);
    if (e != hipSuccess) fprintf(stderr, "cooperative launch failed: %s (grid %d)\n", hipGetErrorString(e), grid_blocks);
}
```

```cpp
#include <hip/hip_runtime.h>
#include <hip/hip_cooperative_groups.h>
#include <cstdio>
namespace cg = cooperative_groups;

#define LAS __attribute__((address_space(3)))
typedef unsigned short bf16_t;
typedef short bf16x8 __attribute__((ext_vector_type(8)));
typedef float f32x4 __attribute__((ext_vector_type(4)));
typedef unsigned u32x4 __attribute__((ext_vector_type(4)));
typedef unsigned u32x2 __attribute__((ext_vector_type(2)));

constexpr int DM = 2048, SEQ = 8192, MROWS = 16384, DFF = 5632, NUP = 11264, NAIN = 6144, NBIN = 4096;
constexpr float RMS_EPS = 1e-5f;
constexpr size_t MiB = 1u << 20;
constexpr size_t OFF_SS = 0;
constexpr size_t OFF_BAR = 512 * 1024;
constexpr size_t OFF_W_AIN = 1 * MiB;
constexpr size_t OFF_W_AOUT = OFF_W_AIN + 24 * MiB;
constexpr size_t OFF_W_UP0 = OFF_W_AOUT + 8 * MiB;
constexpr size_t OFF_W_DN0 = OFF_W_UP0 + 44 * MiB;
constexpr size_t OFF_W_BIN = OFF_W_DN0 + 22 * MiB;
constexpr size_t OFF_W_BOUT = OFF_W_BIN + 16 * MiB;
constexpr size_t OFF_W_UP1 = OFF_W_BOUT + 8 * MiB;
constexpr size_t OFF_W_DN1 = OFF_W_UP1 + 44 * MiB;
constexpr size_t OFF_XB = OFF_W_DN1 + 22 * MiB;
constexpr size_t OFF_BIG = OFF_XB + 64 * MiB;
constexpr size_t OFF_SIDE = OFF_BIG + 192 * MiB;
constexpr size_t WS_NEED = OFF_SIDE + 22 * MiB;

constexpr int LDS_BYTES = 131072 + 64 + 8 * 512;

__device__ __forceinline__ unsigned cvt_pk_bf16(float lo, float hi) { unsigned r; asm volatile("v_cvt_pk_bf16_f32 %0, %1, %2" : "=v"(r) : "v"(lo), "v"(hi)); return r; }
__device__ __forceinline__ float bf_lo(unsigned w) { return __uint_as_float(w << 16); }
__device__ __forceinline__ float bf_hi(unsigned w) { return __uint_as_float(w & 0xffff0000u); }
__device__ __forceinline__ float wave_sum(float v) {
#pragma unroll
    for (int o = 1; o < 64; o <<= 1) v += __shfl_xor(v, o);
    return v;
}
__device__ __forceinline__ float fast_rcp(float x) { return __builtin_amdgcn_rcpf(x); }
__device__ __forceinline__ float gelu_tanh(float x) {
    const float u = 0.7978845608028654f * (x + 0.044715f * x * x * x);
    return x * fast_rcp(1.0f + __builtin_amdgcn_exp2f(-2.8853900817779268f * u));
}
__device__ __forceinline__ float silu(float x) { return x * fast_rcp(1.0f + __builtin_amdgcn_exp2f(-1.4426950408889634f * x)); }
__device__ __forceinline__ float inv_rms(float ss) { return __builtin_amdgcn_rsqf(ss * (1.0f / DM) + RMS_EPS); }


#define XB_TMO      128
#define XB_XCNT(j)  (256  + 64 * (j))
#define XB_XSUB(j)  (1280 + 64 * (j))
#define XB_XGEN(j)  (2304 + 64 * (j))
#define XB_TOP      3328
#define XB_TOPGEN   3392
#define XCD_BAR_WORDS 3456
#define XB_SPIN_CAP (1u << 22)
__device__ __forceinline__ unsigned xb_ld(unsigned* p)              { return __hip_atomic_load(p, __ATOMIC_RELAXED, __HIP_MEMORY_SCOPE_AGENT); }
__device__ __forceinline__ unsigned xb_add(unsigned* p, unsigned v) { return __hip_atomic_fetch_add(p, v, __ATOMIC_RELAXED, __HIP_MEMORY_SCOPE_AGENT); }
__device__ __forceinline__ unsigned xb_xcc_id() { return (unsigned)__builtin_amdgcn_s_getreg((3 << 11) | 20) & 0xFu; }
#define XB_SPIN(cond, bar) do { unsigned _sp = 0; while (cond) { __builtin_amdgcn_s_sleep(1); \
    if ((++_sp & 255u) == 0u) { if (xb_ld(&(bar)[XB_TMO])) break; if (_sp > XB_SPIN_CAP) { atomicAdd(&(bar)[XB_TMO], 1u); break; } } } } while (0)
struct XcdBarrier { unsigned* bar; unsigned x; volatile LAS unsigned* st; };
__device__ __forceinline__ XcdBarrier xcd_barrier_post(unsigned* bar, volatile LAS unsigned* st) {
    XcdBarrier b; b.bar = bar; b.x = xb_xcc_id(); b.st = st;
    if (threadIdx.x == 0) (void)xb_add(&bar[XB_XCNT(b.x)], 1u);
    return b;
}
__device__ __forceinline__ void xcd_barrier_complete(unsigned* bar, unsigned x, unsigned& nloc, unsigned& nx) {
    const unsigned G = gridDim.x * gridDim.y * gridDim.z;
    unsigned sum, cnt, mine, sp = 0u;
    for (;;) {
        sum = 0u; cnt = 0u; mine = 0u;
#pragma unroll
        for (unsigned j = 0; j < 16; ++j) { const unsigned c = xb_ld(&bar[XB_XCNT(j)]); sum += c; cnt += (c > 0u) ? 1u : 0u; mine = (j == x) ? c : mine; }
        if (sum == G) break;
        __builtin_amdgcn_s_sleep(1);
        if ((++sp & 255u) == 0u) { if (xb_ld(&bar[XB_TMO])) break; if (sp > XB_SPIN_CAP) { atomicAdd(&bar[XB_TMO], 1u); break; } }
    }
    nloc = mine > 0u ? mine : 1u; nx = cnt > 0u ? cnt : 1u;
}
__device__ __forceinline__ void xcd_barrier(const XcdBarrier& b) {
    asm volatile("s_waitcnt vmcnt(0)" ::: "memory");
    __syncthreads();
    if (threadIdx.x == 0) {
        unsigned* bar = b.bar;
        __builtin_amdgcn_s_waitcnt(0);
        unsigned nloc = b.st[0], nx = b.st[1];
        if (nloc == 0u) { xcd_barrier_complete(bar, b.x, nloc, nx); b.st[0] = nloc; b.st[1] = nx; }
        const unsigned old = xb_add(&bar[XB_XSUB(b.x)], 1u);
        const unsigned gen = old / nloc;
        if (old + 1u == (gen + 1u) * nloc) {
            __builtin_amdgcn_fence(__ATOMIC_RELEASE, "agent");
            asm volatile("s_waitcnt vmcnt(0)" ::: "memory");
            const unsigned og = xb_add(&bar[XB_TOP], 1u);
            const unsigned tg = og / nx;
            if (og + 1u == (tg + 1u) * nx) xb_add(&bar[XB_TOPGEN], 1u);
            else XB_SPIN(xb_ld(&bar[XB_TOPGEN]) == tg, bar);
            __builtin_amdgcn_fence(__ATOMIC_ACQUIRE, "agent");
            xb_add(&bar[XB_XGEN(b.x)], 1u);
            asm volatile("s_waitcnt vmcnt(0)" ::: "memory");
        } else {
            XB_SPIN(xb_ld(&bar[XB_XGEN(b.x)]) == gen, bar);
            __builtin_amdgcn_fence(__ATOMIC_ACQUIRE, "agent");
            asm volatile("s_waitcnt vmcnt(0)" ::: "memory");
        }
    }
    __syncthreads();
}

constexpr int BM = 256, BK = 64, HALF = 128, HTB = HALF * BK * 2, NXCD = 8, WGM = 4;
__device__ __forceinline__ int lds_byte(int r, int c) { const int st = (r >> 4) * 2 + (c >> 5), rr = r & 15, cc = c & 31, ob = rr * 64 + cc * 2; return st * 1024 + (ob ^ (((ob >> 9) & 1) << 5)); }
__device__ __forceinline__ void stage_rc(int b, int& R, int& C) { const int st = b / 1024, sb = b % 1024, swz = sb ^ (((sb >> 9) & 1) << 5); R = (st >> 1) * 16 + swz / 64; C = (st & 1) * 32 + (swz % 64) / 2; }
__device__ __forceinline__ int perm32(int rho) { const int n = rho >> 4, i = rho & 15; return 8 * (i >> 2) + 4 * n + (i & 3); }

struct Unit { int pm, pn; };
struct StaticOrder {
    int nM, nN, nwg, G, c;
    __device__ void init(int M, int N, int G_, int c_) { nM = M / BM; nN = N / BM; nwg = nM * nN; G = G_; c = c_; }
    __device__ bool next(int i, Unit& u) const {
        const long L = (long)i * G + c; if (L >= nwg) return false;
        int wgid = (int)L; { const int q = nwg / NXCD, r = nwg % NXCD, xcd = wgid % NXCD, off = wgid / NXCD; wgid = (xcd < r ? xcd * (q + 1) : r * (q + 1) + (xcd - r) * q) + off; }
        const int nig = WGM * nN, gid = wgid / nig, fm = gid * WGM, gsz = (nM - fm) < WGM ? (nM - fm) : WGM;
        u.pm = fm + ((wgid % nig) % gsz); u.pn = (wgid % nig) / gsz; return true;
    }
};

template <int MODE> struct Epi {
    bf16_t* O; int ldo; const float* ss_in; float* ss_out; const float* base; float* outf; bf16_t* xb; bf16_t* halo;
    __device__ __forceinline__ void operator()(f32x4 (&acc)[2][2][4][2], const Unit& u, int wr, int wc, int fr, int fq) const {
        const int row0 = u.pm * BM + wr * 64 + fr, col0 = u.pn * BM + wc * 32 + 8 * fq;
#pragma unroll
        for (int ai = 0; ai < 2; ++ai)
#pragma unroll
            for (int m = 0; m < 4; ++m) {
                const int row = row0 + ai * HALF + m * 16;
                if (MODE != 3) {
                    const float inv = inv_rms(ss_in[row]);
                    float sq = 0.f;
#pragma unroll
                    for (int bj = 0; bj < 2; ++bj) {
                        f32x4 v0 = acc[ai][bj][m][0] * inv, v1 = acc[ai][bj][m][1] * inv;
                        if (MODE == 2) {
#pragma unroll
                            for (int j = 0; j < 4; ++j) { v0[j] = gelu_tanh(v0[j]); v1[j] = gelu_tanh(v1[j]); sq += v0[j] * v0[j] + v1[j] * v1[j]; }
                        }
                        u32x4 w; w.x = cvt_pk_bf16(v0[0], v0[1]); w.y = cvt_pk_bf16(v0[2], v0[3]); w.z = cvt_pk_bf16(v1[0], v1[1]); w.w = cvt_pk_bf16(v1[2], v1[3]);
                        *(u32x4*)(O + (size_t)row * ldo + col0 + bj * HALF) = w;
                    }
                    if (MODE == 2) {
                        if (u.pn >= 8) { sq += __shfl_xor(sq, 16); sq += __shfl_xor(sq, 32); if (fq == 0) atomicAdd(ss_out + row, sq); }
                    }
                } else {
                    float sq = 0.f;
#pragma unroll
                    for (int bj = 0; bj < 2; ++bj) {
                        const size_t off = (size_t)row * DM + col0 + bj * HALF;
                        const f32x4 b0 = *(const f32x4*)(base + off), b1 = *(const f32x4*)(base + off + 4);
                        const f32x4 v0 = acc[ai][bj][m][0] + b0, v1 = acc[ai][bj][m][1] + b1;
                        *(f32x4*)(outf + off) = v0; *(f32x4*)(outf + off + 4) = v1;
                        u32x4 w; w.x = cvt_pk_bf16(v0[0], v0[1]); w.y = cvt_pk_bf16(v0[2], v0[3]); w.z = cvt_pk_bf16(v1[0], v1[1]); w.w = cvt_pk_bf16(v1[2], v1[3]);
                        *(u32x4*)(xb + off) = w;
#pragma unroll
                        for (int j = 0; j < 4; ++j) sq += v0[j] * v0[j] + v1[j] * v1[j];
                    }
                    sq += __shfl_xor(sq, 16); sq += __shfl_xor(sq, 32);
                    if (fq == 0) atomicAdd(ss_out + row, sq);
                }
            }
    }
};


template <bool BASE_F32, bool OUT_F32> struct EpiRes {
    const float* basef; float* outf; bf16_t* xb; float* ss_out;
    __device__ __forceinline__ void operator()(f32x4 (&acc)[2][2][4][2], const Unit& u, int wr, int wc, int fr_in, int fq_in) const {
        int fr = fr_in, fq = fq_in; asm volatile("" : "+v"(fr), "+v"(fq));
        const int row0 = u.pm * BM + wr * 64 + fr, col0 = u.pn * BM + wc * 32 + 8 * fq;
#pragma unroll
        for (int ai = 0; ai < 2; ++ai)
#pragma unroll
            for (int m = 0; m < 4; ++m) {
                const int row = row0 + ai * HALF + m * 16;
                float sq = 0.f;
#pragma unroll
                for (int bj = 0; bj < 2; ++bj) {
                    const size_t off = (size_t)row * DM + col0 + bj * HALF;
                    f32x4 b0, b1;
                    if (BASE_F32) { b0 = *(const f32x4*)(basef + off); b1 = *(const f32x4*)(basef + off + 4); }
                    else { const u32x4 w = *(const u32x4*)(xb + off); b0 = (f32x4){bf_lo(w.x), bf_hi(w.x), bf_lo(w.y), bf_hi(w.y)}; b1 = (f32x4){bf_lo(w.z), bf_hi(w.z), bf_lo(w.w), bf_hi(w.w)}; }
                    const f32x4 v0 = acc[ai][bj][m][0] + b0, v1 = acc[ai][bj][m][1] + b1;
                    if (OUT_F32) { *(f32x4*)(outf + off) = v0; *(f32x4*)(outf + off + 4) = v1; }
                    else { u32x4 w; w.x = cvt_pk_bf16(v0[0], v0[1]); w.y = cvt_pk_bf16(v0[2], v0[3]); w.z = cvt_pk_bf16(v1[0], v1[1]); w.w = cvt_pk_bf16(v1[2], v1[3]); *(u32x4*)(xb + off) = w; }
#pragma unroll
                    for (int j = 0; j < 4; ++j) sq += v0[j] * v0[j] + v1[j] * v1[j];
                }
                sq += __shfl_xor(sq, 16); sq += __shfl_xor(sq, 32);
                if (fq == 0) atomicAdd(ss_out + row, sq);
            }
    }
};

__device__ __forceinline__ float dpp_ror1(float v) { return __int_as_float(__builtin_amdgcn_update_dpp(0, __float_as_int(v), 0x121, 0xf, 0xf, false)); }
__device__ __forceinline__ float dpp_ror2(float v) { return __int_as_float(__builtin_amdgcn_update_dpp(0, __float_as_int(v), 0x122, 0xf, 0xf, false)); }
struct EpiFfn {
    bf16_t* act; const float* ss_in; const float* cw; const float* cb; float* side; LAS float* invl;
    __device__ __forceinline__ void operator()(f32x4 (&acc)[2][2][4][2], const Unit& u, int wr, int wc, int fr_in, int fq_in) const {
        int fr = fr_in, fq = fq_in; asm volatile("" : "+v"(fr), "+v"(fq));
        const int rbase = u.pm * BM + wr * 128 + fr, jg0 = u.pn * 128 + wc * 32 + 8 * fq, chunk = u.pm * 2 + wr;
        u32x2 P0[8];
        {
            float inv[8];
#pragma unroll
            for (int k = 0; k < 8; ++k) inv[k] = ss_in[rbase + k * 16];
#pragma unroll
            for (int k = 0; k < 8; ++k) { const float s = inv_rms(inv[k]);
#pragma unroll
                for (int bj = 0; bj < 2; ++bj)
#pragma unroll
                    for (int n = 0; n < 2; ++n) acc[k >> 2][bj][k & 3][n] *= s; }
        }
#pragma unroll
        for (int n = 0; n < 2; ++n) {
            const int jg = jg0 + 4 * n;
            const f32x4 w0g = *(const f32x4*)(cw + jg), w1g = *(const f32x4*)(cw + NUP + jg), w2g = *(const f32x4*)(cw + 2 * NUP + jg), bg = *(const f32x4*)(cb + jg);
            const f32x4 w0a = *(const f32x4*)(cw + DFF + jg), w1a = *(const f32x4*)(cw + NUP + DFF + jg), w2a = *(const f32x4*)(cw + 2 * NUP + DFF + jg), ba = *(const f32x4*)(cb + DFF + jg);
            f32x4 pg = {0.f, 0.f, 0.f, 0.f}, pa = pg;
#pragma unroll
            for (int k = 0; k < 8; ++k) {
                const int ai = k >> 2, m = k & 3;
                const f32x4 ug = acc[ai][0][m][n], ua = acc[ai][1][m][n];
                if (k == 0) { if (fr < 2) { float* sp = side + (size_t)(chunk * 4 + fr) * NUP + jg; *(f32x4*)sp = ug; *(f32x4*)(sp + DFF) = ua; } }
                if (k == 7) { if (fr >= 14) { float* sp = side + (size_t)(chunk * 4 + fr - 12) * NUP + jg; *(f32x4*)sp = ug; *(f32x4*)(sp + DFF) = ua; } }
                float o[4];
#pragma unroll
                for (int e = 0; e < 4; ++e) {
                    const float p1g = dpp_ror1(fr == 15 ? pg[e] : ug[e]), p2g = dpp_ror2(fr >= 14 ? pg[e] : ug[e]);
                    const float p1a = dpp_ror1(fr == 15 ? pa[e] : ua[e]), p2a = dpp_ror2(fr >= 14 ? pa[e] : ua[e]);
                    const float cgv = w0g[e] * p2g + w1g[e] * p1g + w2g[e] * ug[e] + bg[e];
                    const float cav = w0a[e] * p2a + w1a[e] * p1a + w2a[e] * ua[e] + ba[e];
                    o[e] = silu(cgv) * cav;
                }
                u32x2 pk; pk.x = cvt_pk_bf16(o[0], o[1]); pk.y = cvt_pk_bf16(o[2], o[3]);
                if (n == 0) P0[k] = pk;
                else if (k > 0 || fr >= 2) { u32x4 w; w.x = P0[k].x; w.y = P0[k].y; w.z = pk.x; w.w = pk.y; *(u32x4*)(act + (size_t)(rbase + k * 16) * DFF + jg0) = w; }
                pg = ug; pa = ua;
            }
        }
    }
};
__device__ __forceinline__ void phase_ffn_fix(bf16_t* act, const float* side, const float* cw, const float* cb, int gtid, int NT) {
    for (int it = gtid; it < 128 * (DFF / 4); it += NT) {
        const int c = it / (DFF / 4), j = (it - c * (DFF / 4)) * 4;
        const float* s = side + (size_t)(c * 4) * NUP + j;
        const f32x4 g0 = *(const f32x4*)s, g1 = *(const f32x4*)(s + NUP), a0 = *(const f32x4*)(s + DFF), a1 = *(const f32x4*)(s + NUP + DFF);
        f32x4 gA = {0.f, 0.f, 0.f, 0.f}, gB = gA, aA = gA, aB = gA;
        if (c & 63) { const float* sp = s - 2 * NUP; gA = *(const f32x4*)sp; gB = *(const f32x4*)(sp + NUP); aA = *(const f32x4*)(sp + DFF); aB = *(const f32x4*)(sp + NUP + DFF); }
        const f32x4 w0g = *(const f32x4*)(cw + j), w1g = *(const f32x4*)(cw + NUP + j), w2g = *(const f32x4*)(cw + 2 * NUP + j), bg = *(const f32x4*)(cb + j);
        const f32x4 w0a = *(const f32x4*)(cw + DFF + j), w1a = *(const f32x4*)(cw + NUP + DFF + j), w2a = *(const f32x4*)(cw + 2 * NUP + DFF + j), ba = *(const f32x4*)(cb + DFF + j);
        float o0[4], o1[4];
#pragma unroll
        for (int e = 0; e < 4; ++e) {
            o0[e] = silu(w0g[e] * gA[e] + w1g[e] * gB[e] + w2g[e] * g0[e] + bg[e]) * (w0a[e] * aA[e] + w1a[e] * aB[e] + w2a[e] * a0[e] + ba[e]);
            o1[e] = silu(w0g[e] * gB[e] + w1g[e] * g0[e] + w2g[e] * g1[e] + bg[e]) * (w0a[e] * aB[e] + w1a[e] * a0[e] + w2a[e] * a1[e] + ba[e]);
        }
        u32x2 p0, p1; p0.x = cvt_pk_bf16(o0[0], o0[1]); p0.y = cvt_pk_bf16(o0[2], o0[3]); p1.x = cvt_pk_bf16(o1[0], o1[1]); p1.y = cvt_pk_bf16(o1[2], o1[3]);
        *(u32x2*)(act + (size_t)(c * 128) * DFF + j) = p0; *(u32x2*)(act + (size_t)(c * 128 + 1) * DFF + j) = p1;
    }
}

template <class EpiT, bool FFN = false>
__device__ __forceinline__ void gemm_phase(LAS unsigned char* lds, const bf16_t* A, int lda, const bf16_t* Bt, int Mg, int N, int K, const EpiT& E) {
    const int tid = threadIdx.x, wid = __builtin_amdgcn_readfirstlane(tid >> 6), lane = tid & 63, wr = wid >> 2, wc = wid & 3, fr = lane & 15, fq = lane >> 4;
    const int nt = K / BK;
    StaticOrder S; S.init(Mg, N, (int)gridDim.x, (int)blockIdx.x);
    unsigned voffA[2], voffB[2];
#pragma unroll
    for (int i = 0; i < 2; ++i) { int R, C; stage_rc(tid * 16 + i * 8192, R, C); const int Rb = (R & ~31) + perm32(R & 31);
        const int Ra = FFN ? ((R >> 6) * 128 + (R & 63)) : R;
        voffA[i] = (unsigned)(Ra * lda + C) * 2u; voffB[i] = (unsigned)(Rb * K + C) * 2u; }
    const size_t kstep = (size_t)(BK * 2);
    const size_t hstepA = (size_t)(FFN ? 64 : HALF) * lda * 2, hstepB = (size_t)(FFN ? DFF : HALF) * K * 2;
    const size_t tstepA = (size_t)BM * lda * 2, tstepB = (size_t)(FFN ? HALF : BM) * K * 2;
    const unsigned ldsw = (unsigned)wid * 1024u;
    const int aoff = lds_byte(wr * 64 + fr, fq * 8), boff = lds_byte(wc * 32 + fr, fq * 8);
#define PG8_SA(b, h) (((b) * 2 + (h)) * HTB)
#define PG8_SB(b, h) ((4 + (b) * 2 + (h)) * HTB)
#define PG8_STAGE(bufoff, gbase, voff) do { _Pragma("unroll") for (int _i = 0; _i < 2; ++_i) \
        __builtin_amdgcn_global_load_lds((const unsigned*)((const char*)(gbase) + (voff)[_i]), (LAS unsigned*)(lds + (bufoff) + ldsw + _i * 8192), 16, 0, 0); } while (0)
#define PG8_LDA(dst, b, h) do { _Pragma("unroll") for (int m = 0; m < 4; ++m) _Pragma("unroll") for (int k = 0; k < 2; ++k) dst[m][k] = *(const LAS bf16x8*)(lds + PG8_SA(b, h) + aoff + m * 2048 + k * 1024); } while (0)
#define PG8_LDB(dst, b, h) do { _Pragma("unroll") for (int n = 0; n < 2; ++n) _Pragma("unroll") for (int k = 0; k < 2; ++k) dst[n][k] = *(const LAS bf16x8*)(lds + PG8_SB(b, h) + boff + n * 2048 + k * 1024); } while (0)
#define PG8_MMA(ai, bj, At, Bt_) do { __builtin_amdgcn_s_setprio(1); _Pragma("unroll") for (int m = 0; m < 4; ++m) _Pragma("unroll") for (int n = 0; n < 2; ++n) _Pragma("unroll") for (int k = 0; k < 2; ++k) \
        acc[ai][bj][m][n] = __builtin_amdgcn_mfma_f32_16x16x32_bf16(Bt_[n][k], At[m][k], acc[ai][bj][m][n], 0, 0, 0); __builtin_amdgcn_s_setprio(0); } while (0)
#define PG8_WAIT_V(n) asm volatile("s_waitcnt vmcnt(" #n ")" ::: "memory")
#define PG8_WAIT_L(n) asm volatile("s_waitcnt lgkmcnt(" #n ")" ::: "memory")
#define PG8_BAR __builtin_amdgcn_s_barrier()
#define PG8_SCHED __builtin_amdgcn_sched_barrier(0)
    Unit cur, nxt; int ui = 0;
    if (!S.next(0, cur)) return;
    f32x4 acc[2][2][4][2];
#pragma unroll
    for (int a = 0; a < 2; ++a)
#pragma unroll
        for (int b = 0; b < 2; ++b)
#pragma unroll
            for (int m = 0; m < 4; ++m)
#pragma unroll
                for (int n = 0; n < 2; ++n) acc[a][b][m][n] = (f32x4){0.f, 0.f, 0.f, 0.f};
    bf16x8 At[4][2], B0[2][2], B1[2][2];
    const char* cA = (const char*)A + (size_t)cur.pm * tstepA; const char* cB = (const char*)Bt + (size_t)cur.pn * tstepB;
    PG8_STAGE(PG8_SB(0, 0), cB, voffB); PG8_STAGE(PG8_SA(0, 0), cA, voffA); PG8_STAGE(PG8_SB(0, 1), cB + hstepB, voffB); PG8_STAGE(PG8_SA(0, 1), cA + hstepA, voffA);
    if (wr == 1) PG8_BAR;
    PG8_WAIT_V(4); PG8_BAR;
    PG8_STAGE(PG8_SB(1, 0), cB + kstep, voffB); PG8_STAGE(PG8_SA(1, 0), cA + kstep, voffA); PG8_STAGE(PG8_SB(1, 1), cB + hstepB + kstep, voffB);
    PG8_WAIT_V(6); PG8_BAR;
    for (;;) {
        const bool has_next = S.next(ui + 1, nxt);
        const char* nA = has_next ? (const char*)A + (size_t)nxt.pm * tstepA : cA; const char* nB = has_next ? (const char*)Bt + (size_t)nxt.pn * tstepB : cB;
        for (int t = 0; t < nt; t += 2) {
            const bool last = (t == nt - 2);
            const char* a1 = cA + (size_t)(t + 1) * kstep;
            const char* a2 = last ? nA : cA + (size_t)(t + 2) * kstep; const char* b2 = last ? nB : cB + (size_t)(t + 2) * kstep;
            const char* a3 = a2 + kstep; const char* b3 = b2 + kstep;
            PG8_LDB(B0, 0, 0); PG8_SCHED; PG8_LDA(At, 0, 0); PG8_STAGE(PG8_SA(1, 1), a1 + hstepA, voffA);
            PG8_WAIT_L(8); PG8_BAR; PG8_WAIT_L(0); PG8_MMA(0, 0, At, B0); PG8_BAR; PG8_SCHED;
            PG8_LDB(B1, 0, 1); PG8_STAGE(PG8_SB(0, 0), b2, voffB);
            PG8_BAR; PG8_WAIT_L(0); PG8_MMA(0, 1, At, B1); PG8_BAR;
            PG8_LDA(At, 0, 1); PG8_STAGE(PG8_SA(0, 0), a2, voffA);
            PG8_BAR; PG8_WAIT_L(0); PG8_MMA(1, 0, At, B0); PG8_BAR; PG8_SCHED;
            PG8_STAGE(PG8_SB(0, 1), b2 + hstepB, voffB);
            PG8_WAIT_V(6); PG8_BAR; PG8_MMA(1, 1, At, B1); PG8_BAR;
            PG8_LDB(B0, 1, 0); PG8_SCHED; PG8_LDA(At, 1, 0); PG8_STAGE(PG8_SA(0, 1), a2 + hstepA, voffA);
            PG8_WAIT_L(8); PG8_BAR; PG8_WAIT_L(0); PG8_MMA(0, 0, At, B0); PG8_BAR; PG8_SCHED;
            PG8_LDB(B1, 1, 1); PG8_STAGE(PG8_SB(1, 0), b3, voffB);
            PG8_BAR; PG8_WAIT_L(0); PG8_MMA(0, 1, At, B1); PG8_BAR;
            PG8_LDA(At, 1, 1); PG8_STAGE(PG8_SA(1, 0), a3, voffA);
            PG8_BAR; PG8_WAIT_L(0); PG8_MMA(1, 0, At, B0); PG8_BAR; PG8_SCHED;
            PG8_STAGE(PG8_SB(1, 1), b3 + hstepB, voffB);
            PG8_WAIT_V(6); PG8_BAR; PG8_MMA(1, 1, At, B1); PG8_BAR;
        }
        E(acc, cur, wr, wc, fr, fq);
        if (!has_next) break;
#pragma unroll
        for (int a = 0; a < 2; ++a)
#pragma unroll
            for (int b = 0; b < 2; ++b)
#pragma unroll
                for (int m = 0; m < 4; ++m)
#pragma unroll
                    for (int n = 0; n < 2; ++n) acc[a][b][m][n] = (f32x4){0.f, 0.f, 0.f, 0.f};
        cur = nxt; cA = nA; cB = nB; ++ui;
    }
    PG8_WAIT_V(0);
    if (wr == 0) PG8_BAR;
    PG8_BAR;
#undef PG8_SA
#undef PG8_SB
#undef PG8_STAGE
#undef PG8_LDA
#undef PG8_LDB
#undef PG8_MMA
#undef PG8_WAIT_V
#undef PG8_WAIT_L
#undef PG8_BAR
#undef PG8_SCHED
}

__device__ __forceinline__ void p0_transpose_item(const float* W, int K, int N, bf16_t* WT, const float* gain, int item, int lane) {
    const int nblk = N / 64, kb = item / nblk, nb = item - kb * nblk, k0 = 64 * kb, n0 = 64 * nb;
    const float* src = W + (size_t)k0 * N + n0 + lane;
    float v[64];
#pragma unroll
    for (int i = 0; i < 64; ++i) v[i] = src[(size_t)i * N];
    if (gain) {
#pragma unroll
        for (int i = 0; i < 64; ++i) v[i] *= gain[k0 + i];
    }
    bf16_t* dst = WT + (size_t)(n0 + lane) * K + k0;
#pragma unroll
    for (int c = 0; c < 8; ++c) {
        u32x4 o; o.x = cvt_pk_bf16(v[8 * c], v[8 * c + 1]); o.y = cvt_pk_bf16(v[8 * c + 2], v[8 * c + 3]); o.z = cvt_pk_bf16(v[8 * c + 4], v[8 * c + 5]); o.w = cvt_pk_bf16(v[8 * c + 6], v[8 * c + 7]);
        *(u32x4*)(dst + 8 * c) = o;
    }
}

struct Params { const float* in[17]; float* out; unsigned char* ws; };

__device__ __forceinline__ void phase0(const Params& p, LAS unsigned char* lds, int gw, int NGW, int wave, int lane) {
    unsigned char* ws = p.ws;
    constexpr int I_AIN = (DM / 64) * (NAIN / 64), I_SQ = (DM / 64) * (DM / 64), I_UP = (DM / 64) * (NUP / 64), I_DN = (DFF / 64) * (DM / 64), I_BIN = (DM / 64) * (NBIN / 64);
    constexpr int NITEMS = I_AIN + 2 * I_SQ + 2 * I_UP + 2 * I_DN + I_BIN;
    for (int it = gw; it < NITEMS; it += NGW) {
        int r = it;
        if (r < I_AIN) { p0_transpose_item(p.in[2], DM, NAIN, (bf16_t*)(ws + OFF_W_AIN), p.in[1], r, lane); continue; } r -= I_AIN;
        if (r < I_SQ) { p0_transpose_item(p.in[4], DM, DM, (bf16_t*)(ws + OFF_W_AOUT), nullptr, r, lane); continue; } r -= I_SQ;
        if (r < I_UP) { p0_transpose_item(p.in[12], DM, NUP, (bf16_t*)(ws + OFF_W_UP0), p.in[11], r, lane); continue; } r -= I_UP;
        if (r < I_DN) { p0_transpose_item(p.in[15], DFF, DM, (bf16_t*)(ws + OFF_W_DN0), nullptr, r, lane); continue; } r -= I_DN;
        if (r < I_BIN) { p0_transpose_item(p.in[6], DM, NBIN, (bf16_t*)(ws + OFF_W_BIN), p.in[5], r, lane); continue; } r -= I_BIN;
        if (r < I_SQ) { p0_transpose_item(p.in[10], DM, DM, (bf16_t*)(ws + OFF_W_BOUT), nullptr, r, lane); continue; } r -= I_SQ;
        if (r < I_UP) { p0_transpose_item(p.in[12] + (size_t)DM * NUP, DM, NUP, (bf16_t*)(ws + OFF_W_UP1), p.in[11] + DM, r, lane); continue; } r -= I_UP;
        p0_transpose_item(p.in[15] + (size_t)DFF * DM, DFF, DM, (bf16_t*)(ws + OFF_W_DN1), nullptr, r, lane);
    }
    float* ss = (float*)(ws + OFF_SS);
    bf16_t* xb = (bf16_t*)(ws + OFF_XB);
    for (int m = gw; m < MROWS; m += NGW) {
        const f32x4* xr = (const f32x4*)(p.in[0] + (size_t)m * DM) + lane;
        f32x4 v[8]; float s = 0.f;
#pragma unroll
        for (int j = 0; j < 8; ++j) { v[j] = xr[64 * j]; s += (v[j][0] * v[j][0] + v[j][1] * v[j][1]) + (v[j][2] * v[j][2] + v[j][3] * v[j][3]); }
        s = wave_sum(s);
        u32x2* o = (u32x2*)(xb + (size_t)m * DM) + lane;
#pragma unroll
        for (int j = 0; j < 8; ++j) { u32x2 w; w.x = cvt_pk_bf16(v[j][0], v[j][1]); w.y = cvt_pk_bf16(v[j][2], v[j][3]); o[64 * j] = w; }
        if (lane == 0) ss[m] = s;
    }
    if (gw < 8) { unsigned* bw = (unsigned*)(ws + OFF_BAR); for (int i = gw * 64 + lane; i < 3456; i += 512) bw[i] = 0u; }
    for (int i = gw * 64 + lane; i < 5 * MROWS; i += NGW * 64) ss[MROWS + i] = 0.f;
}

__device__ __forceinline__ void phase_mixA(bf16_t* bcx, const float* cw, int gw, int NGW, int lane) {
    for (int it = gw; it < (MROWS / 32) * 4; it += NGW) {
        const int seg = it >> 2, cb = it & 3, t0 = seg * 32, j = cb * 512 + lane * 8;
        float w0[8], w1[8], w2[8], pm2[8], pm1[8];
#pragma unroll
        for (int q = 0; q < 2; ++q) { const f32x4 a = *(const f32x4*)(cw + j + 4 * q), b = *(const f32x4*)(cw + DM + j + 4 * q), c = *(const f32x4*)(cw + 2 * DM + j + 4 * q);
#pragma unroll
            for (int e = 0; e < 4; ++e) { w0[4 * q + e] = a[e]; w1[4 * q + e] = b[e]; w2[4 * q + e] = c[e]; } }
        if ((t0 & (SEQ - 1)) == 0) {
#pragma unroll
            for (int e = 0; e < 8; ++e) { pm2[e] = 0.f; pm1[e] = 0.f; }
        } else {
            const bf16_t* r2 = bcx + (size_t)(t0 - 2) * NAIN + j; const bf16_t* r1 = bcx + (size_t)(t0 - 1) * NAIN + j;
            const u32x4 c2 = *(const u32x4*)(r2 + DM), x2 = *(const u32x4*)(r2 + 2 * DM), c1 = *(const u32x4*)(r1 + DM), x1 = *(const u32x4*)(r1 + 2 * DM);
#pragma unroll
            for (int e = 0; e < 4; ++e) { pm2[2 * e] = bf_lo(c2[e]) * bf_lo(x2[e]); pm2[2 * e + 1] = bf_hi(c2[e]) * bf_hi(x2[e]); pm1[2 * e] = bf_lo(c1[e]) * bf_lo(x1[e]); pm1[2 * e + 1] = bf_hi(c1[e]) * bf_hi(x1[e]); }
        }
#pragma unroll 4
        for (int r = 0; r < 32; ++r) {
            bf16_t* rp = bcx + (size_t)(t0 + r) * NAIN + j;
            const u32x4 gb = *(const u32x4*)rp, gc = *(const u32x4*)(rp + DM), xs = *(const u32x4*)(rp + 2 * DM);
            float y[8];
#pragma unroll
            for (int e = 0; e < 4; ++e) {
                const float p0 = bf_lo(gc[e]) * bf_lo(xs[e]), p1 = bf_hi(gc[e]) * bf_hi(xs[e]);
                y[2 * e] = bf_lo(gb[e]) * (w0[2 * e] * pm2[2 * e] + w1[2 * e] * pm1[2 * e] + w2[2 * e] * p0);
                y[2 * e + 1] = bf_hi(gb[e]) * (w0[2 * e + 1] * pm2[2 * e + 1] + w1[2 * e + 1] * pm1[2 * e + 1] + w2[2 * e + 1] * p1);
                pm2[2 * e] = pm1[2 * e]; pm2[2 * e + 1] = pm1[2 * e + 1]; pm1[2 * e] = p0; pm1[2 * e + 1] = p1;
            }
            u32x4 w; w.x = cvt_pk_bf16(y[0], y[1]); w.y = cvt_pk_bf16(y[2], y[3]); w.z = cvt_pk_bf16(y[4], y[5]); w.w = cvt_pk_bf16(y[6], y[7]);
            *(u32x4*)rp = w;
        }
    }
}

__device__ __forceinline__ void phase_sg(LAS unsigned char* lds, bf16_t* z, const float* wsp, const float* bs, const float* gv, const float* ssv) {
    constexpr int LP = 136;
    LAS bf16_t* As = (LAS bf16_t*)lds;
    LAS bf16_t* Vt = (LAS bf16_t*)(lds + 128 * LP * 2);
    const int tid = threadIdx.x, wid = tid >> 6, lane = tid & 63, fr = lane & 15, fq = lane >> 4, tb = wid >> 2, cb = wid & 3;
    for (int it = blockIdx.x; it < (MROWS / 128) * 8; it += gridDim.x) {
        const int n = it >> 3, h = it & 7, r0 = n * 128, c0 = h * 256;
        {
            const int s4 = (tid & 31) * 4; float iv[4];
#pragma unroll
            for (int i = 0; i < 4; ++i) iv[i] = inv_rms(ssv[r0 + s4 + i]);
#pragma unroll
            for (int i2 = 0; i2 < 8; ++i2) { const int t = (tid >> 5) + i2 * 16; const f32x4 w = *(const f32x4*)(wsp + (size_t)(h * 128 + t) * 128 + s4);
                float a[4];
#pragma unroll
                for (int i = 0; i < 4; ++i) a[i] = (s4 + i <= t) ? w[i] * iv[i] : 0.f;
                u32x2 o; o.x = cvt_pk_bf16(a[0], a[1]); o.y = cvt_pk_bf16(a[2], a[3]);
                *(LAS u32x2*)(As + t * LP + s4) = o; }
        }
#pragma unroll
        for (int i2 = 0; i2 < 8; ++i2) {
            const int q = i2 * 512 + tid, s = q & 127, cc = q >> 7;
            const u32x4 v = *(const u32x4*)(z + (size_t)(r0 + s) * NBIN + DM + c0 + cc * 8);
#pragma unroll
            for (int i = 0; i < 4; ++i) { Vt[(cc * 8 + 2 * i) * LP + s] = (bf16_t)(v[i] & 0xffffu); Vt[(cc * 8 + 2 * i + 1) * LP + s] = (bf16_t)(v[i] >> 16); }
        }
        __syncthreads();
        f32x4 acc[4][4];
#pragma unroll
        for (int mi = 0; mi < 4; ++mi)
#pragma unroll
            for (int ni = 0; ni < 4; ++ni) acc[mi][ni] = (f32x4){0.f, 0.f, 0.f, 0.f};
#pragma unroll
        for (int ks = 0; ks < 4; ++ks) {
            bf16x8 a[4], b[4];
#pragma unroll
            for (int mi = 0; mi < 4; ++mi) a[mi] = *(const LAS bf16x8*)(As + (tb * 64 + mi * 16 + fr) * LP + ks * 32 + fq * 8);
#pragma unroll
            for (int ni = 0; ni < 4; ++ni) b[ni] = *(const LAS bf16x8*)(Vt + (cb * 64 + ni * 16 + fr) * LP + ks * 32 + fq * 8);
#pragma unroll
            for (int mi = 0; mi < 4; ++mi)
#pragma unroll
                for (int ni = 0; ni < 4; ++ni) acc[mi][ni] = __builtin_amdgcn_mfma_f32_16x16x32_bf16(b[ni], a[mi], acc[mi][ni], 0, 0, 0);
        }
#pragma unroll
        for (int mi = 0; mi < 4; ++mi) {
            const int t = tb * 64 + mi * 16 + fr; const float bias = bs[h * 128 + t];
#pragma unroll
            for (int ni = 0; ni < 4; ++ni) {
                const int c = cb * 64 + ni * 16 + 4 * fq;
                const f32x4 g = *(const f32x4*)(gv + c0 + c);
                bf16_t* up = z + (size_t)(r0 + t) * NBIN + c0 + c;
                const u32x2 uu = *(const u32x2*)up;
                const float o0 = bf_lo(uu.x) * (g[0] * acc[mi][ni][0] + bias), o1 = bf_hi(uu.x) * (g[1] * acc[mi][ni][1] + bias);
                const float o2 = bf_lo(uu.y) * (g[2] * acc[mi][ni][2] + bias), o3 = bf_hi(uu.y) * (g[3] * acc[mi][ni][3] + bias);
                u32x2 o; o.x = cvt_pk_bf16(o0, o1); o.y = cvt_pk_bf16(o2, o3);
                *(u32x2*)up = o;
            }
        }
        __syncthreads();
    }
}

__device__ __forceinline__ void phase_final(float* out, const float* ss, const float* g, int gw, int NGW, int lane) {
    for (int m = gw; m < MROWS; m += NGW) {
        const float inv = inv_rms(ss[m]);
        f32x4* xr = (f32x4*)(out + (size_t)m * DM) + lane; const f32x4* gr = (const f32x4*)g + lane;
#pragma unroll
        for (int j = 0; j < 8; ++j) { const f32x4 v = xr[64 * j]; const f32x4 gg = gr[64 * j]; xr[64 * j] = (v * inv) * gg; }
    }
}

__global__ void __launch_bounds__(512, 2) fwd_megakernel(Params p) {
    extern __shared__ __attribute__((aligned(16))) unsigned char lds_raw[];
    LAS unsigned char* lds = (LAS unsigned char*)lds_raw;
    cg::grid_group grid = cg::this_grid();
    const int tid = threadIdx.x, lane = tid & 63, wave = __builtin_amdgcn_readfirstlane(tid >> 6);
    const int gw = blockIdx.x * 8 + wave, NGW = gridDim.x * 8;
    unsigned char* ws = p.ws;
    float* ss = (float*)(ws + OFF_SS);
    float *ss0 = ss, *ss1 = ss + MROWS, *ss2 = ss + 2 * MROWS, *ssv = ss + 3 * MROWS, *ss3 = ss + 4 * MROWS, *ss4 = ss + 5 * MROWS;
    bf16_t* xb = (bf16_t*)(ws + OFF_XB);
    bf16_t* big = (bf16_t*)(ws + OFF_BIG);
    float* side = (float*)(ws + OFF_SIDE);
    float* out = p.out;

    volatile LAS unsigned* bst = (volatile LAS unsigned*)(lds + 131072);
    if (tid < 2) bst[tid] = 0u;
    phase0(p, lds, gw, NGW, wave, lane);
    grid.sync();
    const XcdBarrier xbar = xcd_barrier_post((unsigned*)(ws + OFF_BAR), bst);
#define GSYNC() xcd_barrier(xbar)
    { Epi<0> E{big, NAIN, ss0, nullptr, nullptr, nullptr, nullptr, nullptr};
      gemm_phase(lds, xb, DM, (const bf16_t*)(ws + OFF_W_AIN), MROWS, NAIN, DM, E); }
    GSYNC();
    phase_mixA(big, p.in[3], gw, NGW, lane);
    GSYNC();
    { EpiRes<true, false> E{p.in[0], nullptr, xb, ss1};
      gemm_phase(lds, big, NAIN, (const bf16_t*)(ws + OFF_W_AOUT), MROWS, DM, DM, E); }
    GSYNC();
    { EpiFfn E{big, ss1, p.in[13], p.in[14], side, (LAS float*)(lds + 131072 + 64) + wave * 128};
      gemm_phase<EpiFfn, true>(lds, xb, DM, (const bf16_t*)(ws + OFF_W_UP0), MROWS, NUP, DM, E); }
    GSYNC();
    phase_ffn_fix(big, side, p.in[13], p.in[14], blockIdx.x * 512 + tid, gridDim.x * 512);
    GSYNC();
    { EpiRes<false, false> E{nullptr, nullptr, xb, ss2};
      gemm_phase(lds, big, DFF, (const bf16_t*)(ws + OFF_W_DN0), MROWS, DM, DFF, E); }
    GSYNC();
    { Epi<2> E{big, NBIN, ss2, ssv, nullptr, nullptr, nullptr, nullptr};
      gemm_phase(lds, xb, DM, (const bf16_t*)(ws + OFF_W_BIN), MROWS, NBIN, DM, E); }
    GSYNC();
    phase_sg(lds, big, p.in[8], p.in[9], p.in[7], ssv);
    GSYNC();
    { EpiRes<false, false> E{nullptr, nullptr, xb, ss3};
      gemm_phase(lds, big, NBIN, (const bf16_t*)(ws + OFF_W_BOUT), MROWS, DM, DM, E); }
    GSYNC();
    { EpiFfn E{big, ss3, p.in[13] + 3 * NUP, p.in[14] + NUP, side, (LAS float*)(lds + 131072 + 64) + wave * 128};
      gemm_phase<EpiFfn, true>(lds, xb, DM, (const bf16_t*)(ws + OFF_W_UP1), MROWS, NUP, DM, E); }
    GSYNC();
    phase_ffn_fix(big, side, p.in[13] + 3 * NUP, p.in[14] + NUP, blockIdx.x * 512 + tid, gridDim.x * 512);
    GSYNC();
    { EpiRes<false, true> E{nullptr, out, xb, ss4};
      gemm_phase(lds, big, DFF, (const bf16_t*)(ws + OFF_W_DN1), MROWS, DM, DFF, E); }
    GSYNC();
    phase_final(out, ss4, p.in[16], gw, NGW, lane);
}

extern "C" void kernel_launch(void* const* d_in, const int* in_sizes, int n_in, void* d_out, int out_size, void* d_ws, size_t ws_size, hipStream_t stream) {
    static int grid_blocks = 0;
    if (grid_blocks == 0) {
        if (n_in != 17 || out_size != MROWS * DM || ws_size < WS_NEED) { fprintf(stderr, "kernel_launch: unexpected problem (n_in %d out %d ws %zu need %zu)\n", n_in, out_size, ws_size, (size_t)WS_NEED); grid_blocks = -1; return; }
        int dev = 0, cus = 0, per_cu = 0;
        hipGetDevice(&dev);
        hipDeviceGetAttribute(&cus, hipDeviceAttributeMultiprocessorCount, dev);
        if (hipFuncSetAttribute((const void*)fwd_megakernel, hipFuncAttributeMaxDynamicSharedMemorySize, LDS_BYTES) != hipSuccess) { fprintf(stderr, "kernel_launch: hipFuncSetAttribute failed\n"); grid_blocks = -1; return; }
        if (hipOccupancyMaxActiveBlocksPerMultiprocessor(&per_cu, (const void*)fwd_megakernel, 512, LDS_BYTES) != hipSuccess || per_cu < 1) { fprintf(stderr, "kernel_launch: occupancy query gave %d\n", per_cu); per_cu = 1; }
        (void)hipGetLastError();
        grid_blocks = cus * per_cu;
    }
    if (grid_blocks < 0) return;
    Params p{};
    for (int i = 0; i < 17; ++i) p.in[i] = (const float*)d_in[i];
    p.out = (float*)d_out; p.ws = (unsigned char*)d_ws;
    void* args[] = {&p};
    hipError_t e = hipLaunchCooperativeKernel((const void*)fwd_megakernel, dim3(grid_blocks), dim3(512), args, LDS_BYTES, stream);
    if (e != hipSuccess) fprintf(stderr, "cooperative launch failed: %s (grid %d)\n", hipGetErrorString(e), grid_blocks);
}
```

```cpp
#include <hip/hip_runtime.h>
#include <hip/hip_cooperative_groups.h>
#include <cstdio>
namespace cg = cooperative_groups;

#define LAS __attribute__((address_space(3)))
typedef unsigned short bf16_t;
typedef short bf16x8 __attribute__((ext_vector_type(8)));
typedef float f32x4 __attribute__((ext_vector_type(4)));
typedef unsigned u32x4 __attribute__((ext_vector_type(4)));
typedef unsigned u32x2 __attribute__((ext_vector_type(2)));

constexpr int DM = 2048, SEQ = 8192, MROWS = 16384, DFF = 5632, NUP = 11264, NAIN = 6144, NBIN = 4096;
constexpr float RMS_EPS = 1e-5f;
constexpr size_t MiB = 1u << 20;
constexpr size_t OFF_SS = 0;
constexpr size_t OFF_BAR = 512 * 1024;
constexpr size_t OFF_W_AIN = 1 * MiB;
constexpr size_t OFF_W_AOUT = OFF_W_AIN + 24 * MiB;
constexpr size_t OFF_W_UP0 = OFF_W_AOUT + 8 * MiB;
constexpr size_t OFF_W_DN0 = OFF_W_UP0 + 44 * MiB;
constexpr size_t OFF_W_BIN = OFF_W_DN0 + 22 * MiB;
constexpr size_t OFF_W_BOUT = OFF_W_BIN + 16 * MiB;
constexpr size_t OFF_W_UP1 = OFF_W_BOUT + 8 * MiB;
constexpr size_t OFF_W_DN1 = OFF_W_UP1 + 44 * MiB;
constexpr size_t OFF_XB = OFF_W_DN1 + 22 * MiB;
constexpr size_t OFF_BIG = OFF_XB + 64 * MiB;
constexpr size_t OFF_SIDE = OFF_BIG + 192 * MiB;
constexpr size_t WS_NEED = OFF_SIDE + 22 * MiB;

constexpr int LDS_BYTES = 131072 + 64 + 8 * 512;

__device__ __forceinline__ unsigned cvt_pk_bf16(float lo, float hi) { unsigned r; asm volatile("v_cvt_pk_bf16_f32 %0, %1, %2" : "=v"(r) : "v"(lo), "v"(hi)); return r; }
__device__ __forceinline__ float bf_lo(unsigned w) { return __uint_as_float(w << 16); }
__device__ __forceinline__ float bf_hi(unsigned w) { return __uint_as_float(w & 0xffff0000u); }
__device__ __forceinline__ float wave_sum(float v) {
#pragma unroll
    for (int o = 1; o < 64; o <<= 1) v += __shfl_xor(v, o);
    return v;
}
__device__ __forceinline__ float fast_rcp(float x) { return __builtin_amdgcn_rcpf(x); }
__device__ __forceinline__ float gelu_tanh(float x) {
    const float u = 0.7978845608028654f * (x + 0.044715f * x * x * x);
    return x * fast_rcp(1.0f + __builtin_amdgcn_exp2f(-2.8853900817779268f * u));
}
__device__ __forceinline__ float silu(float x) { return x * fast_rcp(1.0f + __builtin_amdgcn_exp2f(-1.4426950408889634f * x)); }
__device__ __forceinline__ float inv_rms(float ss) { return __builtin_amdgcn_rsqf(ss * (1.0f / DM) + RMS_EPS); }


#define XB_TMO      128
#define XB_XCNT(j)  (256  + 64 * (j))
#define XB_XSUB(j)  (1280 + 64 * (j))
#define XB_XGEN(j)  (2304 + 64 * (j))
#define XB_TOP      3328
#define XB_TOPGEN   3392
#define XCD_BAR_WORDS 3456
#define XB_SPIN_CAP (1u << 22)
__device__ __forceinline__ unsigned xb_ld(unsigned* p)              { return __hip_atomic_load(p, __ATOMIC_RELAXED, __HIP_MEMORY_SCOPE_AGENT); }
__device__ __forceinline__ unsigned xb_add(unsigned* p, unsigned v) { return __hip_atomic_fetch_add(p, v, __ATOMIC_RELAXED, __HIP_MEMORY_SCOPE_AGENT); }
__device__ __forceinline__ unsigned xb_xcc_id() { return (unsigned)__builtin_amdgcn_s_getreg((3 << 11) | 20) & 0xFu; }
#define XB_SPIN(cond, bar) do { unsigned _sp = 0; while (cond) { __builtin_amdgcn_s_sleep(1); \
    if ((++_sp & 255u) == 0u) { if (xb_ld(&(bar)[XB_TMO])) break; if (_sp > XB_SPIN_CAP) { atomicAdd(&(bar)[XB_TMO], 1u); break; } } } } while (0)
struct XcdBarrier { unsigned* bar; unsigned x; volatile LAS unsigned* st; };
__device__ __forceinline__ XcdBarrier xcd_barrier_post(unsigned* bar, volatile LAS unsigned* st) {
    XcdBarrier b; b.bar = bar; b.x = xb_xcc_id(); b.st = st;
    if (threadIdx.x == 0) (void)xb_add(&bar[XB_XCNT(b.x)], 1u);
    return b;
}
__device__ __forceinline__ void xcd_barrier_complete(unsigned* bar, unsigned x, unsigned& nloc, unsigned& nx) {
    const unsigned G = gridDim.x * gridDim.y * gridDim.z;
    unsigned sum, cnt, mine, sp = 0u;
    for (;;) {
        sum = 0u; cnt = 0u; mine = 0u;
#pragma unroll
        for (unsigned j = 0; j < 16; ++j) { const unsigned c = xb_ld(&bar[XB_XCNT(j)]); sum += c; cnt += (c > 0u) ? 1u : 0u; mine = (j == x) ? c : mine; }
        if (sum == G) break;
        __builtin_amdgcn_s_sleep(1);
        if ((++sp & 255u) == 0u) { if (xb_ld(&bar[XB_TMO])) break; if (sp > XB_SPIN_CAP) { atomicAdd(&bar[XB_TMO], 1u); break; } }
    }
    nloc = mine > 0u ? mine : 1u; nx = cnt > 0u ? cnt : 1u;
}
__device__ __forceinline__ void xcd_barrier(const XcdBarrier& b) {
    asm volatile("s_waitcnt vmcnt(0)" ::: "memory");
    __syncthreads();
    if (threadIdx.x == 0) {
        unsigned* bar = b.bar;
        __builtin_amdgcn_s_waitcnt(0);
        unsigned nloc = b.st[0], nx = b.st[1];
        if (nloc == 0u) { xcd_barrier_complete(bar, b.x, nloc, nx); b.st[0] = nloc; b.st[1] = nx; }
        const unsigned old = xb_add(&bar[XB_XSUB(b.x)], 1u);
        const unsigned gen = old / nloc;
        if (old + 1u == (gen + 1u) * nloc) {
            __builtin_amdgcn_fence(__ATOMIC_RELEASE, "agent");
            asm volatile("s_waitcnt vmcnt(0)" ::: "memory");
            const unsigned og = xb_add(&bar[XB_TOP], 1u);
            const unsigned tg = og / nx;
            if (og + 1u == (tg + 1u) * nx) xb_add(&bar[XB_TOPGEN], 1u);
            else XB_SPIN(xb_ld(&bar[XB_TOPGEN]) == tg, bar);
            __builtin_amdgcn_fence(__ATOMIC_ACQUIRE, "agent");
            xb_add(&bar[XB_XGEN(b.x)], 1u);
            asm volatile("s_waitcnt vmcnt(0)" ::: "memory");
        } else {
            XB_SPIN(xb_ld(&bar[XB_XGEN(b.x)]) == gen, bar);
            __builtin_amdgcn_fence(__ATOMIC_ACQUIRE, "agent");
            asm volatile("s_waitcnt vmcnt(0)" ::: "memory");
        }
    }
    __syncthreads();
}

constexpr int BM = 256, BK = 64, HALF = 128, HTB = HALF * BK * 2, NXCD = 8, WGM = 4;
__device__ __forceinline__ int lds_byte(int r, int c) { const int st = (r >> 4) * 2 + (c >> 5), rr = r & 15, cc = c & 31, ob = rr * 64 + cc * 2; return st * 1024 + (ob ^ (((ob >> 9) & 1) << 5)); }
__device__ __forceinline__ void stage_rc(int b, int& R, int& C) { const int st = b / 1024, sb = b % 1024, swz = sb ^ (((sb >> 9) & 1) << 5); R = (st >> 1) * 16 + swz / 64; C = (st & 1) * 32 + (swz % 64) / 2; }
__device__ __forceinline__ int perm32(int rho) { const int n = rho >> 4, i = rho & 15; return 8 * (i >> 2) + 4 * n + (i & 3); }

struct Unit { int pm, pn; };
struct StaticOrder {
    int nM, nN, nwg, G, c;
    __device__ void init(int M, int N, int G_, int c_) { nM = M / BM; nN = N / BM; nwg = nM * nN; G = G_; c = c_; }
    __device__ bool next(int i, Unit& u) const {
        const long L = (long)i * G + c; if (L >= nwg) return false;
        int wgid = (int)L; { const int q = nwg / NXCD, r = nwg % NXCD, xcd = wgid % NXCD, off = wgid / NXCD; wgid = (xcd < r ? xcd * (q + 1) : r * (q + 1) + (xcd - r) * q) + off; }
        const int nig = WGM * nN, gid = wgid / nig, fm = gid * WGM, gsz = (nM - fm) < WGM ? (nM - fm) : WGM;
        u.pm = fm + ((wgid % nig) % gsz); u.pn = (wgid % nig) / gsz; return true;
    }
};

template <int MODE> struct Epi {
    bf16_t* O; int ldo; const float* ss_in; float* ss_out; const float* base; float* outf; bf16_t* xb; bf16_t* halo;
    __device__ __forceinline__ void operator()(f32x4 (&acc)[2][2][4][2], const Unit& u, int wr, int wc, int fr, int fq) const {
        const int row0 = u.pm * BM + wr * 64 + fr, col0 = u.pn * BM + wc * 32 + 8 * fq;
#pragma unroll
        for (int ai = 0; ai < 2; ++ai)
#pragma unroll
            for (int m = 0; m < 4; ++m) {
                const int row = row0 + ai * HALF + m * 16;
                if (MODE != 3) {
                    const float inv = inv_rms(ss_in[row]);
                    float sq = 0.f;
#pragma unroll
                    for (int bj = 0; bj < 2; ++bj) {
                        f32x4 v0 = acc[ai][bj][m][0] * inv, v1 = acc[ai][bj][m][1] * inv;
                        if (MODE == 2) {
#pragma unroll
                            for (int j = 0; j < 4; ++j) { v0[j] = gelu_tanh(v0[j]); v1[j] = gelu_tanh(v1[j]); sq += v0[j] * v0[j] + v1[j] * v1[j]; }
                        }
                        u32x4 w; w.x = cvt_pk_bf16(v0[0], v0[1]); w.y = cvt_pk_bf16(v0[2], v0[3]); w.z = cvt_pk_bf16(v1[0], v1[1]); w.w = cvt_pk_bf16(v1[2], v1[3]);
                        *(u32x4*)(O + (size_t)row * ldo + col0 + bj * HALF) = w;
                    }
                    if (MODE == 2) {
                        if (u.pn >= 8) { sq += __shfl_xor(sq, 16); sq += __shfl_xor(sq, 32); if (fq == 0) atomicAdd(ss_out + row, sq); }
                    }
                } else {
                    float sq = 0.f;
#pragma unroll
                    for (int bj = 0; bj < 2; ++bj) {
                        const size_t off = (size_t)row * DM + col0 + bj * HALF;
                        const f32x4 b0 = *(const f32x4*)(base + off), b1 = *(const f32x4*)(base + off + 4);
                        const f32x4 v0 = acc[ai][bj][m][0] + b0, v1 = acc[ai][bj][m][1] + b1;
                        *(f32x4*)(outf + off) = v0; *(f32x4*)(outf + off + 4) = v1;
                        u32x4 w; w.x = cvt_pk_bf16(v0[0], v0[1]); w.y = cvt_pk_bf16(v0[2], v0[3]); w.z = cvt_pk_bf16(v1[0], v1[1]); w.w = cvt_pk_bf16(v1[2], v1[3]);
                        *(u32x4*)(xb + off) = w;
#pragma unroll
                        for (int j = 0; j < 4; ++j) sq += v0[j] * v0[j] + v1[j] * v1[j];
                    }
                    sq += __shfl_xor(sq, 16); sq += __shfl_xor(sq, 32);
                    if (fq == 0) atomicAdd(ss_out + row, sq);
                }
            }
    }
};


template <bool BASE_F32, bool OUT_F32> struct EpiRes {
    const float* basef; float* outf; bf16_t* xb; float* ss_out;
    __device__ __forceinline__ void operator()(f32x4 (&acc)[2][2][4][2], const Unit& u, int wr, int wc, int fr_in, int fq_in) const {
        int fr = fr_in, fq = fq_in; asm volatile("" : "+v"(fr), "+v"(fq));
        const int row0 = u.pm * BM + wr * 64 + fr, col0 = u.pn * BM + wc * 32 + 8 * fq;
#pragma unroll
        for (int ai = 0; ai < 2; ++ai)
#pragma unroll
            for (int m = 0; m < 4; ++m) {
                const int row = row0 + ai * HALF + m * 16;
                float sq = 0.f;
#pragma unroll
                for (int bj = 0; bj < 2; ++bj) {
                    const size_t off = (size_t)row * DM + col0 + bj * HALF;
                    f32x4 b0, b1;
                    if (BASE_F32) { b0 = *(const f32x4*)(basef + off); b1 = *(const f32x4*)(basef + off + 4); }
                    else { const u32x4 w = *(const u32x4*)(xb + off); b0 = (f32x4){bf_lo(w.x), bf_hi(w.x), bf_lo(w.y), bf_hi(w.y)}; b1 = (f32x4){bf_lo(w.z), bf_hi(w.z), bf_lo(w.w), bf_hi(w.w)}; }
                    const f32x4 v0 = acc[ai][bj][m][0] + b0, v1 = acc[ai][bj][m][1] + b1;
                    if (OUT_F32) { *(f32x4*)(outf + off) = v0; *(f32x4*)(outf + off + 4) = v1; }
                    else { u32x4 w; w.x = cvt_pk_bf16(v0[0], v0[1]); w.y = cvt_pk_bf16(v0[2], v0[3]); w.z = cvt_pk_bf16(v1[0], v1[1]); w.w = cvt_pk_bf16(v1[2], v1[3]); *(u32x4*)(xb + off) = w; }
#pragma unroll
                    for (int j = 0; j < 4; ++j) sq += v0[j] * v0[j] + v1[j] * v1[j];
                }
                sq += __shfl_xor(sq, 16); sq += __shfl_xor(sq, 32);
                if (fq == 0) atomicAdd(ss_out + row, sq);
            }
    }
};

__device__ __forceinline__ float dpp_ror1(float v) { return __int_as_float(__builtin_amdgcn_update_dpp(0, __float_as_int(v), 0x121, 0xf, 0xf, false)); }
__device__ __forceinline__ float dpp_ror2(float v) { return __int_as_float(__builtin_amdgcn_update_dpp(0, __float_as_int(v), 0x122, 0xf, 0xf, false)); }
struct EpiFfn {
    bf16_t* act; const float* ss_in; const float* cw; const float* cb; float* side; LAS float* invl;
    __device__ __forceinline__ void operator()(f32x4 (&acc)[2][2][4][2], const Unit& u, int wr, int wc, int fr_in, int fq_in) const {
        int fr = fr_in, fq = fq_in; asm volatile("" : "+v"(fr), "+v"(fq));
        const int rbase = u.pm * BM + wr * 128 + fr, jg0 = u.pn * 128 + wc * 32 + 8 * fq, chunk = u.pm * 2 + wr;
        u32x2 P0[8];
        {
            float inv[8];
#pragma unroll
            for (int k = 0; k < 8; ++k) inv[k] = ss_in[rbase + k * 16];
#pragma unroll
            for (int k = 0; k < 8; ++k) { const float s = inv_rms(inv[k]);
#pragma unroll
                for (int bj = 0; bj < 2; ++bj)
#pragma unroll
                    for (int n = 0; n < 2; ++n) acc[k >> 2][bj][k & 3][n] *= s; }
        }
#pragma unroll
        for (int n = 0; n < 2; ++n) {
            const int jg = jg0 + 4 * n;
            const f32x4 w0g = *(const f32x4*)(cw + jg), w1g = *(const f32x4*)(cw + NUP + jg), w2g = *(const f32x4*)(cw + 2 * NUP + jg), bg = *(const f32x4*)(cb + jg);
            const f32x4 w0a = *(const f32x4*)(cw + DFF + jg), w1a = *(const f32x4*)(cw + NUP + DFF + jg), w2a = *(const f32x4*)(cw + 2 * NUP + DFF + jg), ba = *(const f32x4*)(cb + DFF + jg);
            f32x4 pg = {0.f, 0.f, 0.f, 0.f}, pa = pg;
#pragma unroll
            for (int k = 0; k < 8; ++k) {
                const int ai = k >> 2, m = k & 3;
                const f32x4 ug = acc[ai][0][m][n], ua = acc[ai][1][m][n];
                if (k == 0) { if (fr < 2) { float* sp = side + (size_t)(chunk * 4 + fr) * NUP + jg; *(f32x4*)sp = ug; *(f32x4*)(sp + DFF) = ua; } }
                if (k == 7) { if (fr >= 14) { float* sp = side + (size_t)(chunk * 4 + fr - 12) * NUP + jg; *(f32x4*)sp = ug; *(f32x4*)(sp + DFF) = ua; } }
                float o[4];
#pragma unroll
                for (int e = 0; e < 4; ++e) {
                    const float p1g = dpp_ror1(fr == 15 ? pg[e] : ug[e]), p2g = dpp_ror2(fr >= 14 ? pg[e] : ug[e]);
                    const float p1a = dpp_ror1(fr == 15 ? pa[e] : ua[e]), p2a = dpp_ror2(fr >= 14 ? pa[e] : ua[e]);
                    const float cgv = w0g[e] * p2g + w1g[e] * p1g + w2g[e] * ug[e] + bg[e];
                    const float cav = w0a[e] * p2a + w1a[e] * p1a + w2a[e] * ua[e] + ba[e];
                    o[e] = silu(cgv) * cav;
                }
                u32x2 pk; pk.x = cvt_pk_bf16(o[0], o[1]); pk.y = cvt_pk_bf16(o[2], o[3]);
                if (n == 0) P0[k] = pk;
                else if (k > 0 || fr >= 2) { u32x4 w; w.x = P0[k].x; w.y = P0[k].y; w.z = pk.x; w.w = pk.y; *(u32x4*)(act + (size_t)(rbase + k * 16) * DFF + jg0) = w; }
                pg = ug; pa = ua;
            }
        }
    }
};
__device__ __forceinline__ void phase_ffn_fix(bf16_t* act, const float* side, const float* cw, const float* cb, int gtid, int NT) {
    for (int it = gtid; it < 128 * (DFF / 4); it += NT) {
        const int c = it / (DFF / 4), j = (it - c * (DFF / 4)) * 4;
        const float* s = side + (size_t)(c * 4) * NUP + j;
        const f32x4 g0 = *(const f32x4*)s, g1 = *(const f32x4*)(s + NUP), a0 = *(const f32x4*)(s + DFF), a1 = *(const f32x4*)(s + NUP + DFF);
        f32x4 gA = {0.f, 0.f, 0.f, 0.f}, gB = gA, aA = gA, aB = gA;
        if (c & 63) { const float* sp = s - 2 * NUP; gA = *(const f32x4*)sp; gB = *(const f32x4*)(sp + NUP); aA = *(const f32x4*)(sp + DFF); aB = *(const f32x4*)(sp + NUP + DFF); }
        const f32x4 w0g = *(const f32x4*)(cw + j), w1g = *(const f32x4*)(cw + NUP + j), w2g = *(const f32x4*)(cw + 2 * NUP + j), bg = *(const f32x4*)(cb + j);
        const f32x4 w0a = *(const f32x4*)(cw + DFF + j), w1a = *(const f32x4*)(cw + NUP + DFF + j), w2a = *(const f32x4*)(cw + 2 * NUP + DFF + j), ba = *(const f32x4*)(cb + DFF + j);
        float o0[4], o1[4];
#pragma unroll
        for (int e = 0; e < 4; ++e) {
            o0[e] = silu(w0g[e] * gA[e] + w1g[e] * gB[e] + w2g[e] * g0[e] + bg[e]) * (w0a[e] * aA[e] + w1a[e] * aB[e] + w2a[e] * a0[e] + ba[e]);
            o1[e] = silu(w0g[e] * gB[e] + w1g[e] * g0[e] + w2g[e] * g1[e] + bg[e]) * (w0a[e] * aB[e] + w1a[e] * a0[e] + w2a[e] * a1[e] + ba[e]);
        }
        u32x2 p0, p1; p0.x = cvt_pk_bf16(o0[0], o0[1]); p0.y = cvt_pk_bf16(o0[2], o0[3]); p1.x = cvt_pk_bf16(o1[0], o1[1]); p1.y = cvt_pk_bf16(o1[2], o1[3]);
        *(u32x2*)(act + (size_t)(c * 128) * DFF + j) = p0; *(u32x2*)(act + (size_t)(c * 128 + 1) * DFF + j) = p1;
    }
}

template <class EpiT, bool FFN = false>
__device__ __forceinline__ void gemm_phase(LAS unsigned char* lds, const bf16_t* A, int lda, const bf16_t* Bt, int Mg, int N, int K, const EpiT& E) {
    const int tid = threadIdx.x, wid = __builtin_amdgcn_readfirstlane(tid >> 6), lane = tid & 63, wr = wid >> 2, wc = wid & 3, fr = lane & 15, fq = lane >> 4;
    const int nt = K / BK;
    StaticOrder S; S.init(Mg, N, (int)gridDim.x, (int)blockIdx.x);
    unsigned voffA[2], voffB[2];
#pragma unroll
    for (int i = 0; i < 2; ++i) { int R, C; stage_rc(tid * 16 + i * 8192, R, C); const int Rb = (R & ~31) + perm32(R & 31);
        const int Ra = FFN ? ((R >> 6) * 128 + (R & 63)) : R;
        voffA[i] = (unsigned)(Ra * lda + C) * 2u; voffB[i] = (unsigned)(Rb * K + C) * 2u; }
    const size_t kstep = (size_t)(BK * 2);
    const size_t hstepA = (size_t)(FFN ? 64 : HALF) * lda * 2, hstepB = (size_t)(FFN ? DFF : HALF) * K * 2;
    const size_t tstepA = (size_t)BM * lda * 2, tstepB = (size_t)(FFN ? HALF : BM) * K * 2;
    const unsigned ldsw = (unsigned)wid * 1024u;
    const int aoff = lds_byte(wr * 64 + fr, fq * 8), boff = lds_byte(wc * 32 + fr, fq * 8);
#define PG8_SA(b, h) (((b) * 2 + (h)) * HTB)
#define PG8_SB(b, h) ((4 + (b) * 2 + (h)) * HTB)
#define PG8_STAGE(bufoff, gbase, voff) do { _Pragma("unroll") for (int _i = 0; _i < 2; ++_i) \
        __builtin_amdgcn_global_load_lds((const unsigned*)((const char*)(gbase) + (voff)[_i]), (LAS unsigned*)(lds + (bufoff) + ldsw + _i * 8192), 16, 0, 0); } while (0)
#define PG8_LDA(dst, b, h) do { _Pragma("unroll") for (int m = 0; m < 4; ++m) _Pragma("unroll") for (int k = 0; k < 2; ++k) dst[m][k] = *(const LAS bf16x8*)(lds + PG8_SA(b, h) + aoff + m * 2048 + k * 1024); } while (0)
#define PG8_LDB(dst, b, h) do { _Pragma("unroll") for (int n = 0; n < 2; ++n) _Pragma("unroll") for (int k = 0; k < 2; ++k) dst[n][k] = *(const LAS bf16x8*)(lds + PG8_SB(b, h) + boff + n * 2048 + k * 1024); } while (0)
#define PG8_MMA(ai, bj, At, Bt_) do { __builtin_amdgcn_s_setprio(1); _Pragma("unroll") for (int m = 0; m < 4; ++m) _Pragma("unroll") for (int n = 0; n < 2; ++n) _Pragma("unroll") for (int k = 0; k < 2; ++k) \
        acc[ai][bj][m][n] = __builtin_amdgcn_mfma_f32_16x16x32_bf16(Bt_[n][k], At[m][k], acc[ai][bj][m][n], 0, 0, 0); __builtin_amdgcn_s_setprio(0); } while (0)
#define PG8_WAIT_V(n) asm volatile("s_waitcnt vmcnt(" #n ")" ::: "memory")
#define PG8_WAIT_L(n) asm volatile("s_waitcnt lgkmcnt(" #n ")" ::: "memory")
#define PG8_BAR __builtin_amdgcn_s_barrier()
#define PG8_SCHED __builtin_amdgcn_sched_barrier(0)
    Unit cur, nxt; int ui = 0;
    if (!S.next(0, cur)) return;
    f32x4 acc[2][2][4][2];
#pragma unroll
    for (int a = 0; a < 2; ++a)
#pragma unroll
        for (int b = 0; b < 2; ++b)
#pragma unroll
            for (int m = 0; m < 4; ++m)
#pragma unroll
                for (int n = 0; n < 2; ++n) acc[a][b][m][n] = (f32x4){0.f, 0.f, 0.f, 0.f};
    bf16x8 At[4][2], B0[2][2], B1[2][2];
    const char* cA = (const char*)A + (size_t)cur.pm * tstepA; const char* cB = (const char*)Bt + (size_t)cur.pn * tstepB;
    PG8_STAGE(PG8_SB(0, 0), cB, voffB); PG8_STAGE(PG8_SA(0, 0), cA, voffA); PG8_STAGE(PG8_SB(0, 1), cB + hstepB, voffB); PG8_STAGE(PG8_SA(0, 1), cA + hstepA, voffA);
    if (wr == 1) PG8_BAR;
    PG8_WAIT_V(4); PG8_BAR;
    PG8_STAGE(PG8_SB(1, 0), cB + kstep, voffB); PG8_STAGE(PG8_SA(1, 0), cA + kstep, voffA); PG8_STAGE(PG8_SB(1, 1), cB + hstepB + kstep, voffB);
    PG8_WAIT_V(6); PG8_BAR;
    for (;;) {
        const bool has_next = S.next(ui + 1, nxt);
        const char* nA = has_next ? (const char*)A + (size_t)nxt.pm * tstepA : cA; const char* nB = has_next ? (const char*)Bt + (size_t)nxt.pn * tstepB : cB;
        for (int t = 0; t < nt; t += 2) {
            const bool last = (t == nt - 2);
            const char* a1 = cA + (size_t)(t + 1) * kstep;
            const char* a2 = last ? nA : cA + (size_t)(t + 2) * kstep; const char* b2 = last ? nB : cB + (size_t)(t + 2) * kstep;
            const char* a3 = a2 + kstep; const char* b3 = b2 + kstep;
            PG8_LDB(B0, 0, 0); PG8_SCHED; PG8_LDA(At, 0, 0); PG8_STAGE(PG8_SA(1, 1), a1 + hstepA, voffA);
            PG8_WAIT_L(8); PG8_BAR; PG8_WAIT_L(0); PG8_MMA(0, 0, At, B0); PG8_BAR; PG8_SCHED;
            PG8_LDB(B1, 0, 1); PG8_STAGE(PG8_SB(0, 0), b2, voffB);
            PG8_BAR; PG8_WAIT_L(0); PG8_MMA(0, 1, At, B1); PG8_BAR;
            PG8_LDA(At, 0, 1); PG8_STAGE(PG8_SA(0, 0), a2, voffA);
            PG8_BAR; PG8_WAIT_L(0); PG8_MMA(1, 0, At, B0); PG8_BAR; PG8_SCHED;
            PG8_STAGE(PG8_SB(0, 1), b2 + hstepB, voffB);
            PG8_WAIT_V(6); PG8_BAR; PG8_MMA(1, 1, At, B1); PG8_BAR;
            PG8_LDB(B0, 1, 0); PG8_SCHED; PG8_LDA(At, 1, 0); PG8_STAGE(PG8_SA(0, 1), a2 + hstepA, voffA);
            PG8_WAIT_L(8); PG8_BAR; PG8_WAIT_L(0); PG8_MMA(0, 0, At, B0); PG8_BAR; PG8_SCHED;
            PG8_LDB(B1, 1, 1); PG8_STAGE(PG8_SB(1, 0), b3, voffB);
            PG8_BAR; PG8_WAIT_L(0); PG8_MMA(0, 1, At, B1); PG8_BAR;
            PG8_LDA(At, 1, 1); PG8_STAGE(PG8_SA(1, 0), a3, voffA);
            PG8_BAR; PG8_WAIT_L(0); PG8_MMA(1, 0, At, B0); PG8_BAR; PG8_SCHED;
            PG8_STAGE(PG8_SB(1, 1), b3 + hstepB, voffB);
            PG8_WAIT_V(6); PG8_BAR; PG8_MMA(1, 1, At, B1); PG8_BAR;
        }
        E(acc, cur, wr, wc, fr, fq);
        if (!has_next) break;
#pragma unroll
        for (int a = 0; a < 2; ++a)
#pragma unroll
            for (int b = 0; b < 2; ++b)
#pragma unroll
                for (int m = 0; m < 4; ++m)
#pragma unroll
                    for (int n = 0; n < 2; ++n) acc[a][b][m][n] = (f32x4){0.f, 0.f, 0.f, 0.f};
        cur = nxt; cA = nA; cB = nB; ++ui;
    }
    PG8_WAIT_V(0);
    if (wr == 0) PG8_BAR;
    PG8_BAR;
#undef PG8_SA
#undef PG8_SB
#undef PG8_STAGE
#undef PG8_LDA
#undef PG8_LDB
#undef PG8_MMA
#undef PG8_WAIT_V
#undef PG8_WAIT_L
#undef PG8_BAR
#undef PG8_SCHED
}

__device__ __forceinline__ void p0_transpose_item(const float* W, int K, int N, bf16_t* WT, const float* gain, int item, int lane) {
    const int nblk = N / 64, kb = item / nblk, nb = item - kb * nblk, k0 = 64 * kb, n0 = 64 * nb;
    const float* src = W + (size_t)k0 * N + n0 + lane;
    float v[64];
#pragma unroll
    for (int i = 0; i < 64; ++i) v[i] = __builtin_nontemporal_load(src + (size_t)i * N);
    if (gain) {
#pragma unroll
        for (int i = 0; i < 64; ++i) v[i] *= gain[k0 + i];
    }
    bf16_t* dst = WT + (size_t)(n0 + lane) * K + k0;
#pragma unroll
    for (int c = 0; c < 8; ++c) {
        u32x4 o; o.x = cvt_pk_bf16(v[8 * c], v[8 * c + 1]); o.y = cvt_pk_bf16(v[8 * c + 2], v[8 * c + 3]); o.z = cvt_pk_bf16(v[8 * c + 4], v[8 * c + 5]); o.w = cvt_pk_bf16(v[8 * c + 6], v[8 * c + 7]);
        *(u32x4*)(dst + 8 * c) = o;
    }
}

struct Params { const float* in[17]; float* out; unsigned char* ws; };

__device__ __forceinline__ void phase0(const Params& p, LAS unsigned char* lds, int gw, int NGW, int wave, int lane) {
    unsigned char* ws = p.ws;
    constexpr int I_AIN = (DM / 64) * (NAIN / 64), I_SQ = (DM / 64) * (DM / 64), I_UP = (DM / 64) * (NUP / 64), I_DN = (DFF / 64) * (DM / 64), I_BIN = (DM / 64) * (NBIN / 64);
    constexpr int NITEMS = I_AIN + 2 * I_SQ + 2 * I_UP + 2 * I_DN + I_BIN;
    for (int it = gw; it < NITEMS; it += NGW) {
        int r = it;
        if (r < I_AIN) { p0_transpose_item(p.in[2], DM, NAIN, (bf16_t*)(ws + OFF_W_AIN), p.in[1], r, lane); continue; } r -= I_AIN;
        if (r < I_SQ) { p0_transpose_item(p.in[4], DM, DM, (bf16_t*)(ws + OFF_W_AOUT), nullptr, r, lane); continue; } r -= I_SQ;
        if (r < I_UP) { p0_transpose_item(p.in[12], DM, NUP, (bf16_t*)(ws + OFF_W_UP0), p.in[11], r, lane); continue; } r -= I_UP;
        if (r < I_DN) { p0_transpose_item(p.in[15], DFF, DM, (bf16_t*)(ws + OFF_W_DN0), nullptr, r, lane); continue; } r -= I_DN;
        if (r < I_BIN) { p0_transpose_item(p.in[6], DM, NBIN, (bf16_t*)(ws + OFF_W_BIN), p.in[5], r, lane); continue; } r -= I_BIN;
        if (r < I_SQ) { p0_transpose_item(p.in[10], DM, DM, (bf16_t*)(ws + OFF_W_BOUT), nullptr, r, lane); continue; } r -= I_SQ;
        if (r < I_UP) { p0_transpose_item(p.in[12] + (size_t)DM * NUP, DM, NUP, (bf16_t*)(ws + OFF_W_UP1), p.in[11] + DM, r, lane); continue; } r -= I_UP;
        p0_transpose_item(p.in[15] + (size_t)DFF * DM, DFF, DM, (bf16_t*)(ws + OFF_W_DN1), nullptr, r, lane);
    }
    float* ss = (float*)(ws + OFF_SS);
    bf16_t* xb = (bf16_t*)(ws + OFF_XB);
    for (int m = gw; m < MROWS; m += NGW) {
        const f32x4* xr = (const f32x4*)(p.in[0] + (size_t)m * DM) + lane;
        f32x4 v[8]; float s = 0.f;
#pragma unroll
        for (int j = 0; j < 8; ++j) { v[j] = __builtin_nontemporal_load(xr + 64 * j); s += (v[j][0] * v[j][0] + v[j][1] * v[j][1]) + (v[j][2] * v[j][2] + v[j][3] * v[j][3]); }
        s = wave_sum(s);
        u32x2* o = (u32x2*)(xb + (size_t)m * DM) + lane;
#pragma unroll
        for (int j = 0; j < 8; ++j) { u32x2 w; w.x = cvt_pk_bf16(v[j][0], v[j][1]); w.y = cvt_pk_bf16(v[j][2], v[j][3]); o[64 * j] = w; }
        if (lane == 0) ss[m] = s;
    }
    if (gw < 8) { unsigned* bw = (unsigned*)(ws + OFF_BAR); for (int i = gw * 64 + lane; i < 3456; i += 512) bw[i] = 0u; }
    for (int i = gw * 64 + lane; i < 5 * MROWS; i += NGW * 64) ss[MROWS + i] = 0.f;
}

__device__ __forceinline__ void phase_mixA(bf16_t* bcx, const float* cw, int gw, int NGW, int lane) {
    for (int it = gw; it < (MROWS / 32) * 4; it += NGW) {
        const int seg = it >> 2, cb = it & 3, t0 = seg * 32, j = cb * 512 + lane * 8;
        float w0[8], w1[8], w2[8], pm2[8], pm1[8];
#pragma unroll
        for (int q = 0; q < 2; ++q) { const f32x4 a = *(const f32x4*)(cw + j + 4 * q), b = *(const f32x4*)(cw + DM + j + 4 * q), c = *(const f32x4*)(cw + 2 * DM + j + 4 * q);
#pragma unroll
            for (int e = 0; e < 4; ++e) { w0[4 * q + e] = a[e]; w1[4 * q + e] = b[e]; w2[4 * q + e] = c[e]; } }
        if ((t0 & (SEQ - 1)) == 0) {
#pragma unroll
            for (int e = 0; e < 8; ++e) { pm2[e] = 0.f; pm1[e] = 0.f; }
        } else {
            const bf16_t* r2 = bcx + (size_t)(t0 - 2) * NAIN + j; const bf16_t* r1 = bcx + (size_t)(t0 - 1) * NAIN + j;
            const u32x4 c2 = *(const u32x4*)(r2 + DM), x2 = *(const u32x4*)(r2 + 2 * DM), c1 = *(const u32x4*)(r1 + DM), x1 = *(const u32x4*)(r1 + 2 * DM);
#pragma unroll
            for (int e = 0; e < 4; ++e) { pm2[2 * e] = bf_lo(c2[e]) * bf_lo(x2[e]); pm2[2 * e + 1] = bf_hi(c2[e]) * bf_hi(x2[e]); pm1[2 * e] = bf_lo(c1[e]) * bf_lo(x1[e]); pm1[2 * e + 1] = bf_hi(c1[e]) * bf_hi(x1[e]); }
        }
#pragma unroll 4
        for (int r = 0; r < 32; ++r) {
            bf16_t* rp = bcx + (size_t)(t0 + r) * NAIN + j;
            const u32x4 gb = *(const u32x4*)rp, gc = *(const u32x4*)(rp + DM), xs = *(const u32x4*)(rp + 2 * DM);
            float y[8];
#pragma unroll
            for (int e = 0; e < 4; ++e) {
                const float p0 = bf_lo(gc[e]) * bf_lo(xs[e]), p1 = bf_hi(gc[e]) * bf_hi(xs[e]);
                y[2 * e] = bf_lo(gb[e]) * (w0[2 * e] * pm2[2 * e] + w1[2 * e] * pm1[2 * e] + w2[2 * e] * p0);
                y[2 * e + 1] = bf_hi(gb[e]) * (w0[2 * e + 1] * pm2[2 * e + 1] + w1[2 * e + 1] * pm1[2 * e + 1] + w2[2 * e + 1] * p1);
                pm2[2 * e] = pm1[2 * e]; pm2[2 * e + 1] = pm1[2 * e + 1]; pm1[2 * e] = p0; pm1[2 * e + 1] = p1;
            }
            u32x4 w; w.x = cvt_pk_bf16(y[0], y[1]); w.y = cvt_pk_bf16(y[2], y[3]); w.z = cvt_pk_bf16(y[4], y[5]); w.w = cvt_pk_bf16(y[6], y[7]);
            *(u32x4*)rp = w;
        }
    }
}

__device__ __forceinline__ void phase_sg(LAS unsigned char* lds, bf16_t* z, const float* wsp, const float* bs, const float* gv, const float* ssv) {
    constexpr int LP = 136;
    LAS bf16_t* As = (LAS bf16_t*)lds;
    LAS bf16_t* Vt = (LAS bf16_t*)(lds + 128 * LP * 2);
    const int tid = threadIdx.x, wid = tid >> 6, lane = tid & 63, fr = lane & 15, fq = lane >> 4, tb = wid >> 2, cb = wid & 3;
    for (int it = blockIdx.x; it < (MROWS / 128) * 8; it += gridDim.x) {
        const int n = it >> 3, h = it & 7, r0 = n * 128, c0 = h * 256;
        {
            const int s4 = (tid & 31) * 4; float iv[4];
#pragma unroll
            for (int i = 0; i < 4; ++i) iv[i] = inv_rms(ssv[r0 + s4 + i]);
#pragma unroll
            for (int i2 = 0; i2 < 8; ++i2) { const int t = (tid >> 5) + i2 * 16; const f32x4 w = *(const f32x4*)(wsp + (size_t)(h * 128 + t) * 128 + s4);
                float a[4];
#pragma unroll
                for (int i = 0; i < 4; ++i) a[i] = (s4 + i <= t) ? w[i] * iv[i] : 0.f;
                u32x2 o; o.x = cvt_pk_bf16(a[0], a[1]); o.y = cvt_pk_bf16(a[2], a[3]);
                *(LAS u32x2*)(As + t * LP + s4) = o; }
        }
#pragma unroll
        for (int i2 = 0; i2 < 8; ++i2) {
            const int q = i2 * 512 + tid, s = q & 127, cc = q >> 7;
            const u32x4 v = *(const u32x4*)(z + (size_t)(r0 + s) * NBIN + DM + c0 + cc * 8);
#pragma unroll
            for (int i = 0; i < 4; ++i) { Vt[(cc * 8 + 2 * i) * LP + s] = (bf16_t)(v[i] & 0xffffu); Vt[(cc * 8 + 2 * i + 1) * LP + s] = (bf16_t)(v[i] >> 16); }
        }
        __syncthreads();
        f32x4 acc[4][4];
#pragma unroll
        for (int mi = 0; mi < 4; ++mi)
#pragma unroll
            for (int ni = 0; ni < 4; ++ni) acc[mi][ni] = (f32x4){0.f, 0.f, 0.f, 0.f};
#pragma unroll
        for (int ks = 0; ks < 4; ++ks) {
            bf16x8 a[4], b[4];
#pragma unroll
            for (int mi = 0; mi < 4; ++mi) a[mi] = *(const LAS bf16x8*)(As + (tb * 64 + mi * 16 + fr) * LP + ks * 32 + fq * 8);
#pragma unroll
            for (int ni = 0; ni < 4; ++ni) b[ni] = *(const LAS bf16x8*)(Vt + (cb * 64 + ni * 16 + fr) * LP + ks * 32 + fq * 8);
#pragma unroll
            for (int mi = 0; mi < 4; ++mi)
#pragma unroll
                for (int ni = 0; ni < 4; ++ni) acc[mi][ni] = __builtin_amdgcn_mfma_f32_16x16x32_bf16(b[ni], a[mi], acc[mi][ni], 0, 0, 0);
        }
#pragma unroll
        for (int mi = 0; mi < 4; ++mi) {
            const int t = tb * 64 + mi * 16 + fr; const float bias = bs[h * 128 + t];
#pragma unroll
            for (int ni = 0; ni < 4; ++ni) {
                const int c = cb * 64 + ni * 16 + 4 * fq;
                const f32x4 g = *(const f32x4*)(gv + c0 + c);
                bf16_t* up = z + (size_t)(r0 + t) * NBIN + c0 + c;
                const u32x2 uu = *(const u32x2*)up;
                const float o0 = bf_lo(uu.x) * (g[0] * acc[mi][ni][0] + bias), o1 = bf_hi(uu.x) * (g[1] * acc[mi][ni][1] + bias);
                const float o2 = bf_lo(uu.y) * (g[2] * acc[mi][ni][2] + bias), o3 = bf_hi(uu.y) * (g[3] * acc[mi][ni][3] + bias);
                u32x2 o; o.x = cvt_pk_bf16(o0, o1); o.y = cvt_pk_bf16(o2, o3);
                *(u32x2*)up = o;
            }
        }
        __syncthreads();
    }
}

__device__ __forceinline__ void phase_final(float* out, const float* ss, const float* g, int gw, int NGW, int lane) {
    for (int m = gw; m < MROWS; m += NGW) {
        const float inv = inv_rms(ss[m]);
        f32x4* xr = (f32x4*)(out + (size_t)m * DM) + lane; const f32x4* gr = (const f32x4*)g + lane;
#pragma unroll
        for (int j = 0; j < 8; ++j) { const f32x4 v = xr[64 * j]; const f32x4 gg = gr[64 * j]; xr[64 * j] = (v * inv) * gg; }
    }
}

__global__ void __launch_bounds__(512, 2) fwd_megakernel(Params p) {
    extern __shared__ __attribute__((aligned(16))) unsigned char lds_raw[];
    LAS unsigned char* lds = (LAS unsigned char*)lds_raw;
    cg::grid_group grid = cg::this_grid();
    const int tid = threadIdx.x, lane = tid & 63, wave = __builtin_amdgcn_readfirstlane(tid >> 6);
    const int gw = blockIdx.x * 8 + wave, NGW = gridDim.x * 8;
    unsigned char* ws = p.ws;
    float* ss = (float*)(ws + OFF_SS);
    float *ss0 = ss, *ss1 = ss + MROWS, *ss2 = ss + 2 * MROWS, *ssv = ss + 3 * MROWS, *ss3 = ss + 4 * MROWS, *ss4 = ss + 5 * MROWS;
    bf16_t* xb = (bf16_t*)(ws + OFF_XB);
    bf16_t* big = (bf16_t*)(ws + OFF_BIG);
    float* side = (float*)(ws + OFF_SIDE);
    float* out = p.out;

    volatile LAS unsigned* bst = (volatile LAS unsigned*)(lds + 131072);
    if (tid < 2) bst[tid] = 0u;
    phase0(p, lds, gw, NGW, wave, lane);
    grid.sync();
    const XcdBarrier xbar = xcd_barrier_post((unsigned*)(ws + OFF_BAR), bst);
#define GSYNC() xcd_barrier(xbar)
    { Epi<0> E{big, NAIN, ss0, nullptr, nullptr, nullptr, nullptr, nullptr};
      gemm_phase(lds, xb, DM, (const bf16_t*)(ws + OFF_W_AIN), MROWS, NAIN, DM, E); }
    GSYNC();
    phase_mixA(big, p.in[3], gw, NGW, lane);
    GSYNC();
    { EpiRes<true, false> E{p.in[0], nullptr, xb, ss1};
      gemm_phase(lds, big, NAIN, (const bf16_t*)(ws + OFF_W_AOUT), MROWS, DM, DM, E); }
    GSYNC();
    { EpiFfn E{big, ss1, p.in[13], p.in[14], side, (LAS float*)(lds + 131072 + 64) + wave * 128};
      gemm_phase<EpiFfn, true>(lds, xb, DM, (const bf16_t*)(ws + OFF_W_UP0), MROWS, NUP, DM, E); }
    GSYNC();
    phase_ffn_fix(big, side, p.in[13], p.in[14], blockIdx.x * 512 + tid, gridDim.x * 512);
    GSYNC();
    { EpiRes<false, false> E{nullptr, nullptr, xb, ss2};
      gemm_phase(lds, big, DFF, (const bf16_t*)(ws + OFF_W_DN0), MROWS, DM, DFF, E); }
    GSYNC();
    { Epi<2> E{big, NBIN, ss2, ssv, nullptr, nullptr, nullptr, nullptr};
      gemm_phase(lds, xb, DM, (const bf16_t*)(ws + OFF_W_BIN), MROWS, NBIN, DM, E); }
    GSYNC();
    phase_sg(lds, big, p.in[8], p.in[9], p.in[7], ssv);
    GSYNC();
    { EpiRes<false, false> E{nullptr, nullptr, xb, ss3};
      gemm_phase(lds, big, NBIN, (const bf16_t*)(ws + OFF_W_BOUT), MROWS, DM, DM, E); }
    GSYNC();
    { EpiFfn E{big, ss3, p.in[13] + 3 * NUP, p.in[14] + NUP, side, (LAS float*)(lds + 131072 + 64) + wave * 128};
      gemm_phase<EpiFfn, true>(lds, xb, DM, (const bf16_t*)(ws + OFF_W_UP1), MROWS, NUP, DM, E); }
    GSYNC();
    phase_ffn_fix(big, side, p.in[13] + 3 * NUP, p.in[14] + NUP, blockIdx.x * 512 + tid, gridDim.x * 512);
    GSYNC();
    { EpiRes<false, true> E{nullptr, out, xb, ss4};
      gemm_phase(lds, big, DFF, (const bf16_t*)(ws + OFF_W_DN1), MROWS, DM, DFF, E); }
    GSYNC();
    phase_final(out, ss4, p.in[16], gw, NGW, lane);
}

extern "C" void kernel_launch(void* const* d_in, const int* in_sizes, int n_in, void* d_out, int out_size, void* d_ws, size_t ws_size, hipStream_t stream) {
    static int grid_blocks = 0;
    if (grid_blocks == 0) {
        if (n_in != 17 || out_size != MROWS * DM || ws_size < WS_NEED) { fprintf(stderr, "kernel_launch: unexpected problem (n_in %d out %d ws %zu need %zu)\n", n_in, out_size, ws_size, (size_t)WS_NEED); grid_blocks = -1; return; }
        int dev = 0, cus = 0, per_cu = 0;
        hipGetDevice(&dev);
        hipDeviceGetAttribute(&cus, hipDeviceAttributeMultiprocessorCount, dev);
        if (hipFuncSetAttribute((const void*)fwd_megakernel, hipFuncAttributeMaxDynamicSharedMemorySize, LDS_BYTES) != hipSuccess) { fprintf(stderr, "kernel_launch: hipFuncSetAttribute failed\n"); grid_blocks = -1; return; }
        if (hipOccupancyMaxActiveBlocksPerMultiprocessor(&per_cu, (const void*)fwd_megakernel, 512, LDS_BYTES) != hipSuccess || per_cu < 1) { fprintf(stderr, "kernel_launch: occupancy query gave %d\n", per_cu); per_cu = 1; }
        (void)hipGetLastError();
        grid_blocks = cus * per_cu;
    }
    if (grid_blocks < 0) return;
    Params p{};
    for (int i = 0; i < 17; ++i) p.in[i] = (const float*)d_in[i];
    p.out = (float*)d_out; p.ws = (unsigned char*)d_ws;
    void* args[] = {&p};
    hipError_t e = hipLaunchCooperativeKernel((const void*)fwd_megakernel, dim3(grid_blocks), dim3(512), args, LDS_BYTES, stream);
    if (e != hipSuccess) fprintf(stderr, "cooperative launch failed: %s (grid %d)\n", hipGetErrorString(e), grid_blocks);
}
```
